# Optimizing an MI355X kernel written in HIP

```python
import math
import jax, jax.numpy as jnp
from jax import lax
import numpy as np

D_MODEL = 1024
BATCH = 8
SEQ = 2048
DEPTH = 4
DEC_BATCH = 128
DEC_SEQ = 1
PAST_LEN = 16384
PAGE_SIZE = 128

D_RNN = D_MODEL
RG_BLOCKS = 16
RG_BLOCK = D_RNN // RG_BLOCKS
RG_C = 8.0
CONV_W = 4
GDN_HEADS = 8
GDN_DK = 128
GDN_DV = 128
GDN_QK = GDN_HEADS * GDN_DK
GDN_VW = GDN_HEADS * GDN_DV
GDN_CONV_CH = 2 * GDN_QK + GDN_VW
CHUNK = 64
D_FF = 2816
ALPHA = (2 * DEPTH) ** 0.25
BETA_INIT = (8 * DEPTH) ** -0.25
LN_EPS = 1e-5
RMS_EPS = 1e-6
SPLITS = (D_RNN, D_RNN, GDN_QK, GDN_QK, GDN_VW, GDN_VW, GDN_HEADS, GDN_HEADS, D_MODEL, D_MODEL)
D_IN = 2 * D_RNN + 2 * GDN_QK + 2 * GDN_VW + 2 * GDN_HEADS + 2 * D_MODEL

kernel_name = "hybrid_rglru_gdn_macaron_deepnorm_step"


def layer_norm(x, g, b):
    xf = x.astype(jnp.float32)
    mu = jnp.mean(xf, -1, keepdims=True)
    var = jnp.mean(jnp.square(xf - mu), -1, keepdims=True)
    return ((xf - mu) * lax.rsqrt(var + LN_EPS) * g.astype(jnp.float32) + b.astype(jnp.float32)).astype(x.dtype)


def swiglu(x, w1, w3, w2):
    return (jax.nn.silu(x @ w1) * (x @ w3)) @ w2


def causal_conv(x, buf, w):
    T = x.shape[1]
    xx = jnp.concatenate([buf.astype(x.dtype), x], axis=1)
    y = xx[:, 0:T] * w[0]
    for j in range(1, CONV_W):
        y = y + xx[:, j:j + T] * w[j]
    return y, xx[:, -(CONV_W - 1):]


def rg_lru(x, h0, w_r, b_r, w_i, b_i, lam):
    B, T, _ = x.shape
    xb = x.reshape(B, T, RG_BLOCKS, RG_BLOCK)
    r = jax.nn.sigmoid(jnp.einsum('btnc,ncd->btnd', xb, w_r).reshape(B, T, D_RNN) + b_r).astype(jnp.float32)
    i = jax.nn.sigmoid(jnp.einsum('btnc,ncd->btnd', xb, w_i).reshape(B, T, D_RNN) + b_i)
    log_a = -RG_C * r * jax.nn.softplus(-lam.astype(jnp.float32))
    a = jnp.exp(log_a)
    bterm = jnp.sqrt(-jnp.expm1(2.0 * log_a)) * (i * x).astype(jnp.float32)
    bterm = bterm.at[:, 0].add(a[:, 0] * h0.astype(jnp.float32))

    def comb(e1, e2):
        a1, b1 = e1
        a2, b2 = e2
        return a1 * a2, a2 * b1 + b2

    _, h = lax.associative_scan(comb, (a, bterm), axis=1)
    return h.astype(x.dtype), h[:, -1]


def gated_delta_chunked(q, k, v, g, beta, S0):
    B, T, H, _ = q.shape
    C = min(CHUNK, T)
    N = -(-T // C)
    pad = N * C - T

    def prep(t):
        t = jnp.pad(t, [(0, 0), (0, pad)] + [(0, 0)] * (t.ndim - 2))
        t = jnp.moveaxis(t, 2, 1)
        return t.reshape((B, H, N, C) + t.shape[3:])

    q, k, v, g, beta = prep(q), prep(k), prep(v), prep(g), prep(beta)
    gc = jnp.cumsum(g, axis=-1)
    causal = jnp.tril(jnp.ones((C, C), bool))
    strict = jnp.tril(jnp.ones((C, C), bool), -1)
    diff = gc[..., :, None] - gc[..., None, :]
    decay = jnp.where(causal, jnp.exp(jnp.where(causal, diff, 0.0)), 0.0)
    kb = k * beta[..., None]
    vb = v * beta[..., None]
    L = jnp.where(strict, jnp.einsum('bhncd,bhnsd->bhncs', kb, k) * decay, 0.0)
    eye = jnp.eye(C, dtype=jnp.float32)
    rhs = jnp.concatenate([vb, kb * jnp.exp(gc)[..., None]], axis=-1)
    sol = lax.linalg.triangular_solve(eye + L, rhs, left_side=True, lower=True)
    u, w = sol[..., :GDN_DV], sol[..., GDN_DV:]
    a_intra = jnp.where(causal, jnp.einsum('bhncd,bhnsd->bhncs', q, k) * decay, 0.0)
    g_last = gc[..., -1]
    k_tail = k * jnp.exp(g_last[..., None] - gc)[..., None]
    q_dec = q * jnp.exp(gc)[..., None]
    xs = tuple(jnp.moveaxis(t, 2, 0) for t in (q_dec, k_tail, u, w, a_intra, g_last))

    def step(S, inp):
        qd, kt, ui, wi, ai, gl = inp
        v_new = ui - jnp.einsum('bhck,bhkv->bhcv', wi, S)
        o = jnp.einsum('bhck,bhkv->bhcv', qd, S) + jnp.einsum('bhcs,bhsv->bhcv', ai, v_new)
        S = S * jnp.exp(gl)[..., None, None] + jnp.einsum('bhck,bhcv->bhkv', kt, v_new)
        return S, o

    S, o = lax.scan(step, S0, xs)
    o = jnp.moveaxis(o, 0, 2).reshape(B, H, N * C, GDN_DV)[:, :, :T]
    return jnp.moveaxis(o, 1, 2), S


def l2norm(t):
    return t * lax.rsqrt(jnp.sum(jnp.square(t), -1, keepdims=True) + RMS_EPS)


def hybrid_mixer(x, h0, rc0, S0, gc0, w_in, b_in, rg_conv_w, rg_conv_b, rg_wr, rg_br, rg_wi, rg_bi,
                 rg_lambda, gdn_conv_w, gdn_a_log, gdn_dt_bias, gdn_norm_w, w_o):
    B, T, _ = x.shape
    proj = x @ w_in + b_in
    idx = [int(s) for s in np.cumsum(SPLITS)[:-1]]
    rg_x, rg_y, q, k, v, z, gdn_a, gdn_b, gate_a, gate_b = jnp.split(proj, idx, axis=-1)
    xc, rc_new = causal_conv(rg_x, rc0, rg_conv_w)
    xc = xc + rg_conv_b
    hseq, h_last = rg_lru(xc, h0, rg_wr, rg_br, rg_wi, rg_bi, rg_lambda)
    out_a = hseq * jax.nn.gelu(rg_y)
    qkv, gc_new = causal_conv(jnp.concatenate([q, k, v], axis=-1), gc0, gdn_conv_w)
    qkv = jax.nn.silu(qkv)
    q, k, v = jnp.split(qkv, [GDN_QK, 2 * GDN_QK], axis=-1)
    q = l2norm(q.reshape(B, T, GDN_HEADS, GDN_DK).astype(jnp.float32)) * (GDN_DK ** -0.5)
    k = l2norm(k.reshape(B, T, GDN_HEADS, GDN_DK).astype(jnp.float32))
    v = v.reshape(B, T, GDN_HEADS, GDN_DV).astype(jnp.float32)
    beta = jax.nn.sigmoid(gdn_b.astype(jnp.float32))
    g = -jnp.exp(gdn_a_log.astype(jnp.float32)) * jax.nn.softplus(
        gdn_a.astype(jnp.float32) + gdn_dt_bias.astype(jnp.float32))
    o, S_new = gated_delta_chunked(q, k, v, g, beta, S0.astype(jnp.float32))
    o = o * lax.rsqrt(jnp.mean(jnp.square(o), -1, keepdims=True) + RMS_EPS) * gdn_norm_w.astype(jnp.float32)
    out_b = o.reshape(B, T, GDN_VW).astype(x.dtype) * jax.nn.silu(z)
    merged = jax.nn.sigmoid(gate_a) * out_a + jax.nn.sigmoid(gate_b) * out_b
    new_state = (h_last.astype(h0.dtype), rc_new.astype(rc0.dtype), S_new.astype(S0.dtype), gc_new.astype(gc0.dtype))
    return merged @ w_o, new_state


def decoder_layer(x, h0, rc0, S0, gc0, ln1_g, ln1_b, ffn1_w1, ffn1_w3, ffn1_w2, w_in, b_in,
                  rg_conv_w, rg_conv_b, rg_wr, rg_br, rg_wi, rg_bi, rg_lambda, gdn_conv_w, gdn_a_log,
                  gdn_dt_bias, gdn_norm_w, w_o, ln2_g, ln2_b, ffn2_w1, ffn2_w3, ffn2_w2, ln3_g, ln3_b):
    x = layer_norm(ALPHA * x + 0.5 * swiglu(x, ffn1_w1, ffn1_w3, ffn1_w2), ln1_g, ln1_b)
    m, st = hybrid_mixer(x, h0, rc0, S0, gc0, w_in, b_in, rg_conv_w, rg_conv_b, rg_wr, rg_br, rg_wi,
                         rg_bi, rg_lambda, gdn_conv_w, gdn_a_log, gdn_dt_bias, gdn_norm_w, w_o)
    x = layer_norm(ALPHA * x + m, ln2_g, ln2_b)
    x = layer_norm(ALPHA * x + 0.5 * swiglu(x, ffn2_w1, ffn2_w3, ffn2_w2), ln3_g, ln3_b)
    return x, st


def trunk(x, h0, rc0, S0, gc0, params):
    hs, rcs, Ss, gcs = [], [], [], []
    for l in range(DEPTH):
        x, (h, rc, S, gc) = decoder_layer(x, h0[l], rc0[l], S0[l], gc0[l], *[p[l] for p in params])
        hs.append(h)
        rcs.append(rc)
        Ss.append(S)
        gcs.append(gc)
    return x, jnp.stack(hs), jnp.stack(rcs), jnp.stack(Ss), jnp.stack(gcs)


def setup_inputs(seed: int = 0) -> dict:
    key = jax.random.key(seed)
    ks = iter(jax.random.split(key, 48))

    def nrm(shape, scale):
        return jax.random.normal(next(ks), shape, jnp.float32) * scale

    L, D = DEPTH, D_MODEL
    x_prompt = nrm((BATCH, SEQ, D), 1.0)
    x_sample = nrm((DEC_BATCH, DEC_SEQ, D), 1.0)
    state_rglru_h = nrm((L, DEC_BATCH, D_RNN), 0.5)
    state_rglru_conv = nrm((L, DEC_BATCH, CONV_W - 1, D_RNN), 1.0)
    state_gdn_S = nrm((L, DEC_BATCH, GDN_HEADS, GDN_DK, GDN_DV), 0.1)
    state_gdn_conv = nrm((L, DEC_BATCH, CONV_W - 1, GDN_CONV_CH), 1.0)

    ln1_g = 1.0 + nrm((L, D), 0.02)
    ln1_b = nrm((L, D), 0.02)
    ffn1_w1 = nrm((L, D, D_FF), D ** -0.5)
    ffn1_w3 = nrm((L, D, D_FF), D ** -0.5)
    ffn1_w2 = nrm((L, D_FF, D), BETA_INIT * D_FF ** -0.5)
    w_in = nrm((L, D, D_IN), D ** -0.5)
    v_start = 2 * D_RNN + 2 * GDN_QK
    w_in = w_in.at[:, :, v_start:v_start + GDN_VW].multiply(BETA_INIT)
    b_in = nrm((L, D_IN), 0.01)
    rg_conv_w = nrm((L, CONV_W, D_RNN), CONV_W ** -0.5)
    rg_conv_b = nrm((L, D_RNN), 0.01)
    rg_wr = nrm((L, RG_BLOCKS, RG_BLOCK, RG_BLOCK), RG_BLOCK ** -0.5)
    rg_br = nrm((L, D_RNN), 0.01)
    rg_wi = nrm((L, RG_BLOCKS, RG_BLOCK, RG_BLOCK), RG_BLOCK ** -0.5)
    rg_bi = nrm((L, D_RNN), 0.01)
    u = jax.random.uniform(next(ks), (L, D_RNN), jnp.float32, 0.9, 0.999)
    a0 = u ** (1.0 / RG_C)
    rg_lambda = jnp.log(a0) - jnp.log1p(-a0)
    gdn_conv_w = nrm((L, CONV_W, GDN_CONV_CH), CONV_W ** -0.5)
    gdn_a_log = jnp.log(jax.random.uniform(next(ks), (L, GDN_HEADS), jnp.float32, 1.0, 16.0))
    dt = jnp.exp(jax.random.uniform(next(ks), (L, GDN_HEADS), jnp.float32, math.log(1e-3), math.log(1e-1)))
    gdn_dt_bias = dt + jnp.log(-jnp.expm1(-dt))
    gdn_norm_w = 1.0 + nrm((L, GDN_DV), 0.02)
    w_o = nrm((L, D, D), BETA_INIT * D ** -0.5)
    ln2_g = 1.0 + nrm((L, D), 0.02)
    ln2_b = nrm((L, D), 0.02)
    ffn2_w1 = nrm((L, D, D_FF), D ** -0.5)
    ffn2_w3 = nrm((L, D, D_FF), D ** -0.5)
    ffn2_w2 = nrm((L, D_FF, D), BETA_INIT * D_FF ** -0.5)
    ln3_g = 1.0 + nrm((L, D), 0.02)
    ln3_b = nrm((L, D), 0.02)
    return {"x_prompt": x_prompt, "x_sample": x_sample,
            "state_rglru_h": state_rglru_h, "state_rglru_conv": state_rglru_conv,
            "state_gdn_S": state_gdn_S, "state_gdn_conv": state_gdn_conv,
            "ln1_g": ln1_g, "ln1_b": ln1_b, "ffn1_w1": ffn1_w1, "ffn1_w3": ffn1_w3, "ffn1_w2": ffn1_w2,
            "w_in": w_in, "b_in": b_in, "rg_conv_w": rg_conv_w, "rg_conv_b": rg_conv_b,
            "rg_wr": rg_wr, "rg_br": rg_br, "rg_wi": rg_wi, "rg_bi": rg_bi, "rg_lambda": rg_lambda,
            "gdn_conv_w": gdn_conv_w, "gdn_a_log": gdn_a_log, "gdn_dt_bias": gdn_dt_bias,
            "gdn_norm_w": gdn_norm_w, "w_o": w_o, "ln2_g": ln2_g, "ln2_b": ln2_b,
            "ffn2_w1": ffn2_w1, "ffn2_w3": ffn2_w3, "ffn2_w2": ffn2_w2, "ln3_g": ln3_g, "ln3_b": ln3_b}


def reference(x_prompt, x_sample, state_rglru_h, state_rglru_conv, state_gdn_S, state_gdn_conv,
              ln1_g, ln1_b, ffn1_w1, ffn1_w3, ffn1_w2, w_in, b_in, rg_conv_w, rg_conv_b, rg_wr, rg_br,
              rg_wi, rg_bi, rg_lambda, gdn_conv_w, gdn_a_log, gdn_dt_bias, gdn_norm_w, w_o, ln2_g, ln2_b,
              ffn2_w1, ffn2_w3, ffn2_w2, ln3_g, ln3_b):
    params = (ln1_g, ln1_b, ffn1_w1, ffn1_w3, ffn1_w2, w_in, b_in, rg_conv_w, rg_conv_b, rg_wr, rg_br,
              rg_wi, rg_bi, rg_lambda, gdn_conv_w, gdn_a_log, gdn_dt_bias, gdn_norm_w, w_o, ln2_g, ln2_b,
              ffn2_w1, ffn2_w3, ffn2_w2, ln3_g, ln3_b)
    Bp = x_prompt.shape[0]
    dt = x_prompt.dtype
    y_prompt, p_h, p_rc, p_S, p_gc = trunk(
        x_prompt,
        jnp.zeros((DEPTH, Bp, D_RNN), dt),
        jnp.zeros((DEPTH, Bp, CONV_W - 1, D_RNN), dt),
        jnp.zeros((DEPTH, Bp, GDN_HEADS, GDN_DK, GDN_DV), dt),
        jnp.zeros((DEPTH, Bp, CONV_W - 1, GDN_CONV_CH), dt),
        params)
    y_sample, s_h, s_rc, s_S, s_gc = trunk(
        x_sample, state_rglru_h, state_rglru_conv, state_gdn_S, state_gdn_conv, params)
    return (y_prompt, y_sample, p_h, p_rc, p_S, p_gc, s_h, s_rc, s_S, s_gc)
```

```cpp
#include <hip/hip_runtime.h>
#include <hip/hip_cooperative_groups.h>
#include <cstdio>
namespace cg = cooperative_groups;

#ifndef COOP
#define COOP 1
#endif
#ifndef PHM
#define PHM 0xFFFFF
#endif
#define PON(k) ((PHM >> (k)) & 1)
#ifndef DBL
#define DBL 0
#endif
#ifndef XSYNC
#define XSYNC 0
#endif

#define LAS __attribute__((address_space(3)))
typedef unsigned short bf16_t;
typedef short bf16x8 __attribute__((ext_vector_type(8)));
typedef float f32x4 __attribute__((ext_vector_type(4)));
typedef unsigned u32x4 __attribute__((ext_vector_type(4)));
typedef unsigned u32x2 __attribute__((ext_vector_type(2)));

constexpr int D = 1024, SEQ = 2048, NB = 8, DEPTH = 4, DEC = 128, DFF = 2816;
constexpr int MP = NB * SEQ;
constexpr int MV = MP + DEC;
constexpr int MPAD = 16640;
constexpr int NH = 8, CCH = 3072, DIN = 8208, PN = 8448;
constexpr int NCHK = 32;
constexpr float ALPHA = 1.681792830507429f;
constexpr int LDS_BYTES = 144 * 1024;

constexpr int PC_RGX = 0, PC_RGY = 1024, PC_Q = 2048, PC_Z = 5120, PC_GA = 6144, PC_GB = 7168, PC_A = 8192, PC_B = 8200;

constexpr size_t O_YP = 0, O_YS = O_YP + (size_t)MP * D, O_PH = O_YS + (size_t)DEC * D, O_PRC = O_PH + (size_t)DEPTH * NB * D,
                 O_PS = O_PRC + (size_t)DEPTH * NB * 3 * D, O_PGC = O_PS + (size_t)DEPTH * NB * NH * 128 * 128,
                 O_SH = O_PGC + (size_t)DEPTH * NB * 3 * CCH, O_SRC = O_SH + (size_t)DEPTH * DEC * D,
                 O_SS = O_SRC + (size_t)DEPTH * DEC * 3 * D, O_SGC = O_SS + (size_t)DEPTH * DEC * NH * 128 * 128,
                 O_END = O_SGC + (size_t)DEPTH * DEC * 3 * CCH;

constexpr size_t LW_UP1 = 0, LW_DN1 = 5767168, LW_WIN = 8650752, LW_WO = 17301504, LW_UP2 = 18350080, LW_DN2 = 24117248, LW_END = 27000832;
constexpr size_t al256(size_t x) { return (x + 255) & ~(size_t)255; }
constexpr size_t WS_WT = 0;
constexpr size_t WS_BIASP = al256(WS_WT + (size_t)DEPTH * LW_END * 2);
constexpr size_t WS_RGW = al256(WS_BIASP + (size_t)DEPTH * PN * 4);
constexpr size_t WS_XF = al256(WS_RGW + (size_t)DEPTH * 16 * 2 * 4 * 2 * 64 * 8 * 2);
constexpr size_t WS_XB = al256(WS_XF + (size_t)MPAD * D * 4);
constexpr size_t WS_P = al256(WS_XB + (size_t)MPAD * D * 2);
constexpr size_t WS_MG = al256(WS_P + (size_t)MPAD * PN * 2);
constexpr size_t WS_OA = al256(WS_MG + (size_t)MPAD * D * 2);
constexpr size_t WS_PA = al256(WS_OA + (size_t)MP * D * 2);
constexpr size_t WS_O = al256(WS_PA + (size_t)MP * D * 2);
constexpr size_t WS_TOT = al256(WS_O + (size_t)MP * D * 4);
constexpr size_t WS_PREP = al256(WS_TOT + (size_t)2 * NB * NCHK * D * 4);
constexpr int NCI = NB * NH * NCHK;
constexpr size_t PR_QD = 0, PR_KT = PR_QD + (size_t)NCI * 8192 * 2, PR_WQ = PR_KT + (size_t)NCI * 8192 * 2, PR_UU = PR_WQ + (size_t)NCI * 8192 * 2,
                 PR_AI = PR_UU + (size_t)NCI * 8192 * 4, PR_GL = PR_AI + (size_t)NCI * 4096 * 2, PR_END = PR_GL + (size_t)NCI * 4;
constexpr size_t WS_BAR = al256(WS_PREP + PR_END);
constexpr size_t WS_XCH = WS_BAR + 1024;
constexpr size_t WS_END = WS_XCH + (size_t)64 * 256 * 4 * 8;
static_assert(PR_END >= (size_t)MPAD * D * 4, "Ypre alias");

struct Params { const float* in[32]; float* out; unsigned char* ws; };

__device__ __forceinline__ void grid_barrier(unsigned* bar, unsigned target) {
    asm volatile("s_waitcnt vmcnt(0) lgkmcnt(0)" ::: "memory");
    __syncthreads();
    if (threadIdx.x == 0) {
        __builtin_amdgcn_fence(__ATOMIC_RELEASE, "agent");
        asm volatile("s_waitcnt vmcnt(0)" ::: "memory");
        __hip_atomic_fetch_add(bar, 1u, __ATOMIC_RELAXED, __HIP_MEMORY_SCOPE_AGENT);
        while (__hip_atomic_load(bar, __ATOMIC_RELAXED, __HIP_MEMORY_SCOPE_AGENT) < target) __builtin_amdgcn_s_sleep(40);
        __builtin_amdgcn_fence(__ATOMIC_ACQUIRE, "agent");
        asm volatile("s_waitcnt vmcnt(0)" ::: "memory");
    }
    __syncthreads();
}

__device__ __forceinline__ float bf2f(unsigned short b) { return __uint_as_float(((unsigned)b) << 16); }
__device__ __forceinline__ unsigned pk2(float lo, float hi) { unsigned r; asm("v_cvt_pk_bf16_f32 %0, %1, %2" : "=v"(r) : "v"(lo), "v"(hi)); return r; }
__device__ __forceinline__ unsigned short f2bf(float f) { return (unsigned short)(pk2(f, f) & 0xffffu); }
__device__ __forceinline__ float blo(unsigned w) { return __uint_as_float(w << 16); }
__device__ __forceinline__ float bhi(unsigned w) { return __uint_as_float(w & 0xffff0000u); }
__device__ __forceinline__ float sigmoidf_(float x) { return __builtin_amdgcn_rcpf(1.0f + __expf(-x)); }
__device__ __forceinline__ float siluf_(float x) { return x * __builtin_amdgcn_rcpf(1.0f + __expf(-x)); }
__device__ __forceinline__ float softplusf_(float x) { const float e = __expf(-fabsf(x)); const float l = (e < 0.01f) ? e * (1.0f - e * (0.5f - e * 0.33333334f)) : __logf(1.0f + e); return fmaxf(x, 0.f) + l; }
__device__ __forceinline__ float one_minus_exp(float t) { return (t > -0.02f) ? -t * (1.0f + t * (0.5f + t * 0.16666667f)) : 1.0f - __expf(t); }
__device__ __forceinline__ float geluf_(float x) { const float y = 0.7978845608028654f * (x + 0.044715f * x * x * x); const float t = 1.0f - 2.0f * __builtin_amdgcn_rcpf(__expf(2.0f * y) + 1.0f); return 0.5f * x * (1.0f + t); }
__device__ __forceinline__ void unpack8(const u32x4 r, float* o) { o[0] = blo(r.x); o[1] = bhi(r.x); o[2] = blo(r.y); o[3] = bhi(r.y); o[4] = blo(r.z); o[5] = bhi(r.z); o[6] = blo(r.w); o[7] = bhi(r.w); }
__device__ __forceinline__ u32x4 pack8(const float* v) { u32x4 w; w.x = pk2(v[0], v[1]); w.y = pk2(v[2], v[3]); w.z = pk2(v[4], v[5]); w.w = pk2(v[6], v[7]); return w; }
__device__ __forceinline__ float wave_sum(float s) { s += __shfl_xor(s, 32); s += __shfl_xor(s, 16); s += __shfl_xor(s, 8); s += __shfl_xor(s, 4); s += __shfl_xor(s, 2); s += __shfl_xor(s, 1); return s; }

namespace pg8 {
constexpr int BM = 256, BK = 64, HALF = 128, HTB = HALF * BK * 2, STAGE_BYTES = 8 * HTB, NXCD = 8, WGM = 8;
__device__ __forceinline__ int lds_byte(int r, int c) { const int st = (r >> 4) * 2 + (c >> 5), rr = r & 15, cc = c & 31, ob = rr * 64 + cc * 2; return st * 1024 + (ob ^ (((ob >> 9) & 1) << 5)); }
__device__ __forceinline__ void stage_rc(int b, int& R, int& C) { const int st = b / 1024, sb = b % 1024, swz = sb ^ (((sb >> 9) & 1) << 5); R = (st >> 1) * 16 + swz / 64; C = (st & 1) * 32 + (swz % 64) / 2; }
__device__ __forceinline__ int perm32(int rho) { const int n = rho >> 4, i = rho & 15; return 8 * (i >> 2) + 4 * n + (i & 3); }
struct Unit { int pm, pn; };
struct Gemm { const bf16_t* A; const bf16_t* Bt; int M, N, K; };
struct StaticOrder {
    int nM, nN, nwg, G, c;
    __device__ void init(int M, int N, int G_, int c_) { nM = M / BM; nN = N / BM; nwg = nM * nN; G = G_; c = c_; }
    __device__ bool next(int i, Unit& u) const {
        const long L = (long)i * G + c; if (L >= nwg) return false;
        int wgid = (int)L; { const int q = nwg / NXCD, r = nwg % NXCD, xcd = wgid % NXCD, off = wgid / NXCD; wgid = (xcd < r ? xcd * (q + 1) : r * (q + 1) + (xcd - r) * q) + off; }
        const int nig = WGM * nN, gid = wgid / nig, fm = gid * WGM, gsz = (nM - fm) < WGM ? (nM - fm) : WGM;
        u.pm = fm + ((wgid % nig) % gsz); u.pn = (wgid % nig) / gsz; return true;
    }
};
__device__ __forceinline__ unsigned cvt_pk_bf16(float lo, float hi) { unsigned r; asm volatile("v_cvt_pk_bf16_f32 %0, %1, %2" : "=v"(r) : "v"(lo), "v"(hi)); return r; }

struct EpiSwiglu {
    static constexpr bool PERM = true, AFTER_DRAIN = false;
    bf16_t* H; int ldh;
    __device__ __forceinline__ void operator()(const f32x4 (&acc)[2][2][4][2], const Unit& u, int wr, int wc, int fr, int fq) const {
        const int row0 = u.pm * BM + wr * 64 + fr, col0 = u.pn * HALF + wc * 32 + 8 * fq;
#pragma unroll
        for (int ai = 0; ai < 2; ++ai)
#pragma unroll
            for (int m = 0; m < 4; ++m) {
                bf16_t* rowp = H + (size_t)(row0 + ai * HALF + m * 16) * ldh + col0;
                float o[8];
#pragma unroll
                for (int n = 0; n < 2; ++n)
#pragma unroll
                    for (int j = 0; j < 4; ++j) { const float a = acc[ai][0][m][n][j], b = acc[ai][1][m][n][j]; o[n * 4 + j] = siluf_(a) * b; }
                u32x4 w; w.x = cvt_pk_bf16(o[0], o[1]); w.y = cvt_pk_bf16(o[2], o[3]); w.z = cvt_pk_bf16(o[4], o[5]); w.w = cvt_pk_bf16(o[6], o[7]);
                *(u32x4*)rowp = w;
            }
    }
};
struct EpiProj {
    static constexpr bool PERM = true, AFTER_DRAIN = false;
    bf16_t* O; int ldc; const float* bias;
    __device__ __forceinline__ void operator()(const f32x4 (&acc)[2][2][4][2], const Unit& u, int wr, int wc, int fr, int fq) const {
        const int row0 = u.pm * BM + wr * 64 + fr, col0 = u.pn * BM + wc * 32 + 8 * fq;
        f32x4 bv[2][2];
#pragma unroll
        for (int bj = 0; bj < 2; ++bj)
#pragma unroll
            for (int n = 0; n < 2; ++n) bv[bj][n] = *(const f32x4*)(bias + col0 + bj * HALF + 4 * n);
#pragma unroll
        for (int ai = 0; ai < 2; ++ai)
#pragma unroll
            for (int m = 0; m < 4; ++m) {
                bf16_t* rowp = O + (size_t)(row0 + ai * HALF + m * 16) * ldc + col0;
#pragma unroll
                for (int bj = 0; bj < 2; ++bj) {
                    const f32x4 v0 = acc[ai][bj][m][0] + bv[bj][0], v1 = acc[ai][bj][m][1] + bv[bj][1];
                    u32x4 w; w.x = cvt_pk_bf16(v0[0], v0[1]); w.y = cvt_pk_bf16(v0[2], v0[3]); w.z = cvt_pk_bf16(v1[0], v1[1]); w.w = cvt_pk_bf16(v1[2], v1[3]);
                    *(u32x4*)(rowp + bj * HALF) = w;
                }
            }
    }
};
struct EpiResid {
    static constexpr bool PERM = false, AFTER_DRAIN = false;
    float* Y; const float* R; int ldc; float alpha, s;
    __device__ __forceinline__ void operator()(const f32x4 (&acc)[2][2][4][2], const Unit& u, int wr, int wc, int fr, int fq) const {
        const int row0 = u.pm * BM + wr * 64 + fr, col0 = u.pn * BM + wc * 32 + 4 * fq;
#pragma unroll
        for (int ai = 0; ai < 2; ++ai)
#pragma unroll
            for (int m = 0; m < 4; ++m) {
                const size_t ro = (size_t)(row0 + ai * HALF + m * 16) * ldc + col0;
#pragma unroll
                for (int bj = 0; bj < 2; ++bj)
#pragma unroll
                    for (int n = 0; n < 2; ++n) { const f32x4 r = *(const f32x4*)(R + ro + bj * HALF + n * 16); *(f32x4*)(Y + ro + bj * HALF + n * 16) = r * alpha + acc[ai][bj][m][n] * s; }
            }
    }
};

struct EpiResidLN {
    static constexpr bool PERM = false, AFTER_DRAIN = true;
    float* Xf; bf16_t* Xb; float* out; const float* g; const float* b; float alpha, s; float* xbuf; unsigned* cnt; unsigned gen;
    __device__ __forceinline__ void fused(f32x4 (&acc)[2][2][4][2], const Unit& u, int wr, int wc, int fr, int fq, LAS unsigned char* lds, const int tid) const {
        typedef float f32x2 __attribute__((ext_vector_type(2)));
        LAS f32x2* tab = (LAS f32x2*)lds;
        LAS f32x2* stat = (LAS f32x2*)(lds + 8192);
        const int row0 = u.pm * BM + wr * 64 + fr, col0 = u.pn * BM + wc * 32 + 4 * fq;
#pragma unroll
        for (int ai = 0; ai < 2; ++ai)
#pragma unroll
            for (int m = 0; m < 4; ++m) {
                const size_t ro = (size_t)(row0 + ai * HALF + m * 16) * 1024 + col0;
                float s1 = 0.f, s2 = 0.f;
#pragma unroll
                for (int bj = 0; bj < 2; ++bj)
#pragma unroll
                    for (int n = 0; n < 2; ++n) { const f32x4 r = *(const f32x4*)(Xf + ro + bj * HALF + n * 16); const f32x4 y = r * alpha + acc[ai][bj][m][n] * s; acc[ai][bj][m][n] = y;
                        s1 += (y[0] + y[1]) + (y[2] + y[3]); s2 += (y[0] * y[0] + y[1] * y[1]) + (y[2] * y[2] + y[3] * y[3]); }
                s1 += __shfl_xor(s1, 16); s1 += __shfl_xor(s1, 32); s2 += __shfl_xor(s2, 16); s2 += __shfl_xor(s2, 32);
                if (fq == 0) tab[(ai * HALF + wr * 64 + m * 16 + fr) * 4 + wc] = (f32x2){s1, s2};
            }
        __syncthreads();
        if (tid < 256) { const f32x2 a = tab[tid * 4], b2 = tab[tid * 4 + 1], c = tab[tid * 4 + 2], d = tab[tid * 4 + 3];
            *(f32x2*)(xbuf + (((size_t)u.pm * 4 + u.pn) * 256 + tid) * 2) = (f32x2){(a.x + b2.x) + (c.x + d.x), (a.y + b2.y) + (c.y + d.y)}; }
        asm volatile("s_waitcnt vmcnt(0)" ::: "memory");
        __syncthreads();
        if (tid == 0) {
            __builtin_amdgcn_fence(__ATOMIC_RELEASE, "agent");
            asm volatile("s_waitcnt vmcnt(0)" ::: "memory");
            __hip_atomic_fetch_add(cnt + u.pm, 1u, __ATOMIC_RELAXED, __HIP_MEMORY_SCOPE_AGENT);
            while (__hip_atomic_load(cnt + u.pm, __ATOMIC_RELAXED, __HIP_MEMORY_SCOPE_AGENT) < 4u * gen) __builtin_amdgcn_s_sleep(10);
            __builtin_amdgcn_fence(__ATOMIC_ACQUIRE, "agent");
            asm volatile("s_waitcnt vmcnt(0)" ::: "memory");
        }
        __syncthreads();
        if (tid < 256) { const float* xp = xbuf + ((size_t)u.pm * 4 * 256 + tid) * 2;
            const f32x2 q0 = *(const f32x2*)xp, q1 = *(const f32x2*)(xp + 512), q2 = *(const f32x2*)(xp + 1024), q3 = *(const f32x2*)(xp + 1536);
            const float mean = ((q0.x + q1.x) + (q2.x + q3.x)) * (1.0f / 1024.0f), ex2 = ((q0.y + q1.y) + (q2.y + q3.y)) * (1.0f / 1024.0f);
            stat[tid] = (f32x2){mean, rsqrtf(fmaxf(ex2 - mean * mean, 0.f) + 1e-5f)}; }
        __syncthreads();
#pragma unroll
        for (int ai = 0; ai < 2; ++ai)
#pragma unroll
            for (int m = 0; m < 4; ++m) {
                const f32x2 st = stat[ai * HALF + wr * 64 + m * 16 + fr];
                const size_t ro = (size_t)(row0 + ai * HALF + m * 16) * 1024 + col0;
#pragma unroll
                for (int bj = 0; bj < 2; ++bj)
#pragma unroll
                    for (int n = 0; n < 2; ++n) { const int c = col0 + bj * HALF + n * 16; const f32x4 gv = *(const f32x4*)(g + c), bv = *(const f32x4*)(b + c);
                        const f32x4 y = (acc[ai][bj][m][n] - st.x) * st.y * gv + bv; const size_t o = ro + bj * HALF + n * 16;
                        *(f32x4*)(Xf + o) = y; u32x2 w; w.x = cvt_pk_bf16(y[0], y[1]); w.y = cvt_pk_bf16(y[2], y[3]); *(u32x2*)(Xb + o) = w;
                        if (out) *(f32x4*)(out + o) = y; }
            }
    }
};

template <class Epi>
__device__ __forceinline__ void gemm_phase(LAS unsigned char* lds, const Gemm g, const StaticOrder& S, const Epi& E, const int tid) {
    const int wid = __builtin_amdgcn_readfirstlane(tid >> 6), lane = tid & 63, wr = wid >> 2, wc = wid & 3, fr = lane & 15, fq = lane >> 4;
    const int K = g.K, nt = K / BK;
    unsigned voffA[2], voffB[2];
#pragma unroll
    for (int i = 0; i < 2; ++i) { int R, C; stage_rc(tid * 16 + i * 8192, R, C); const int Rb = Epi::PERM ? ((R & ~31) + perm32(R & 31)) : R;
        voffA[i] = (unsigned)(R * K + C) * 2u; voffB[i] = (unsigned)(Rb * K + C) * 2u; }
    const size_t kstep = (size_t)(BK * 2);
    const size_t hstep = (size_t)HALF * K * 2;
    const size_t tstep = 2 * hstep;
    const unsigned ldsw = (unsigned)wid * 1024u;
    const int aoff = lds_byte(wr * 64 + fr, fq * 8), boff = lds_byte(wc * 32 + fr, fq * 8);
#define PG8_SA(b, h) (((b) * 2 + (h)) * HTB)
#define PG8_SB(b, h) ((4 + (b) * 2 + (h)) * HTB)
#define PG8_STAGE(bufoff, gbase, voff) do { _Pragma("unroll") for (int _i = 0; _i < 2; ++_i) \
        __builtin_amdgcn_global_load_lds((const unsigned*)((const char*)(gbase) + (voff)[_i]), (LAS unsigned*)(lds + (bufoff) + ldsw + _i * 8192), 16, 0, 0); } while (0)
#define PG8_LDA(dst, b, h) do { _Pragma("unroll") for (int m = 0; m < 4; ++m) _Pragma("unroll") for (int k = 0; k < 2; ++k) dst[m][k] = *(const LAS bf16x8*)(lds + PG8_SA(b, h) + aoff + m * 2048 + k * 1024); } while (0)
#define PG8_LDB(dst, b, h) do { _Pragma("unroll") for (int n = 0; n < 2; ++n) _Pragma("unroll") for (int k = 0; k < 2; ++k) dst[n][k] = *(const LAS bf16x8*)(lds + PG8_SB(b, h) + boff + n * 2048 + k * 1024); } while (0)
#define PG8_MMA(ai, bj, At, Bt) do { __builtin_amdgcn_s_setprio(1); _Pragma("unroll") for (int m = 0; m < 4; ++m) _Pragma("unroll") for (int n = 0; n < 2; ++n) _Pragma("unroll") for (int k = 0; k < 2; ++k) \
        acc[ai][bj][m][n] = __builtin_amdgcn_mfma_f32_16x16x32_bf16(Bt[n][k], At[m][k], acc[ai][bj][m][n], 0, 0, 0); __builtin_amdgcn_s_setprio(0); } while (0)
#define PG8_WAIT_V(n) asm volatile("s_waitcnt vmcnt(" #n ")" ::: "memory")
#define PG8_WAIT_L(n) asm volatile("s_waitcnt lgkmcnt(" #n ")" ::: "memory")
#define PG8_BAR __builtin_amdgcn_s_barrier()
#define PG8_SCHED __builtin_amdgcn_sched_barrier(0)
    Unit cur, nxt; int ui = 0;
    if (!S.next(0, cur)) return;
    f32x4 acc[2][2][4][2];
#pragma unroll
    for (int a = 0; a < 2; ++a)
#pragma unroll
        for (int b = 0; b < 2; ++b)
#pragma unroll
            for (int m = 0; m < 4; ++m)
#pragma unroll
                for (int n = 0; n < 2; ++n) acc[a][b][m][n] = (f32x4){0.f, 0.f, 0.f, 0.f};
    bf16x8 At[4][2], B0[2][2], B1[2][2];
    const char* cA = (const char*)g.A + (size_t)cur.pm * tstep; const char* cB = (const char*)g.Bt + (size_t)cur.pn * tstep;
    PG8_STAGE(PG8_SB(0, 0), cB, voffB); PG8_STAGE(PG8_SA(0, 0), cA, voffA); PG8_STAGE(PG8_SB(0, 1), cB + hstep, voffB); PG8_STAGE(PG8_SA(0, 1), cA + hstep, voffA);
    if (wr == 1) PG8_BAR;
    PG8_WAIT_V(4); PG8_BAR;
    PG8_STAGE(PG8_SB(1, 0), cB + kstep, voffB); PG8_STAGE(PG8_SA(1, 0), cA + kstep, voffA); PG8_STAGE(PG8_SB(1, 1), cB + hstep + kstep, voffB);
    PG8_WAIT_V(6); PG8_BAR;
    for (;;) {
        const bool has_next = S.next(ui + 1, nxt);
        const char* nA = has_next ? (const char*)g.A + (size_t)nxt.pm * tstep : cA; const char* nB = has_next ? (const char*)g.Bt + (size_t)nxt.pn * tstep : cB;
        for (int t = 0; t < nt; t += 2) {
            const bool last = (t == nt - 2);
            const char* a1 = cA + (size_t)(t + 1) * kstep;
            const char* a2 = last ? nA : cA + (size_t)(t + 2) * kstep; const char* b2 = last ? nB : cB + (size_t)(t + 2) * kstep;
            const char* a3 = a2 + kstep; const char* b3 = b2 + kstep;
            PG8_LDB(B0, 0, 0); PG8_SCHED; PG8_LDA(At, 0, 0); PG8_STAGE(PG8_SA(1, 1), a1 + hstep, voffA);
            PG8_WAIT_L(8); PG8_BAR; PG8_WAIT_L(0); PG8_MMA(0, 0, At, B0); PG8_BAR; PG8_SCHED;
            PG8_LDB(B1, 0, 1); PG8_STAGE(PG8_SB(0, 0), b2, voffB);
            PG8_BAR; PG8_WAIT_L(0); PG8_MMA(0, 1, At, B1); PG8_BAR;
            PG8_LDA(At, 0, 1); PG8_STAGE(PG8_SA(0, 0), a2, voffA);
            PG8_BAR; PG8_WAIT_L(0); PG8_MMA(1, 0, At, B0); PG8_BAR; PG8_SCHED;
            PG8_STAGE(PG8_SB(0, 1), b2 + hstep, voffB);
            PG8_WAIT_V(6); PG8_BAR; PG8_MMA(1, 1, At, B1); PG8_BAR;
            PG8_LDB(B0, 1, 0); PG8_SCHED; PG8_LDA(At, 1, 0); PG8_STAGE(PG8_SA(0, 1), a2 + hstep, voffA);
            PG8_WAIT_L(8); PG8_BAR; PG8_WAIT_L(0); PG8_MMA(0, 0, At, B0); PG8_BAR; PG8_SCHED;
            PG8_LDB(B1, 1, 1); PG8_STAGE(PG8_SB(1, 0), b3, voffB);
            PG8_BAR; PG8_WAIT_L(0); PG8_MMA(0, 1, At, B1); PG8_BAR;
            PG8_LDA(At, 1, 1); PG8_STAGE(PG8_SA(1, 0), a3, voffA);
            PG8_BAR; PG8_WAIT_L(0); PG8_MMA(1, 0, At, B0); PG8_BAR; PG8_SCHED;
            PG8_STAGE(PG8_SB(1, 1), b3 + hstep, voffB);
            PG8_WAIT_V(6); PG8_BAR; PG8_MMA(1, 1, At, B1); PG8_BAR;
        }
        if constexpr (!Epi::AFTER_DRAIN) E(acc, cur, wr, wc, fr, fq);
        if (!has_next) break;
#pragma unroll
        for (int a = 0; a < 2; ++a)
#pragma unroll
            for (int b = 0; b < 2; ++b)
#pragma unroll
                for (int m = 0; m < 4; ++m)
#pragma unroll
                    for (int n = 0; n < 2; ++n) acc[a][b][m][n] = (f32x4){0.f, 0.f, 0.f, 0.f};
        cur = nxt; cA = nA; cB = nB; ++ui;
    }
    PG8_WAIT_V(0);
    if (wr == 0) PG8_BAR;
    PG8_BAR;
    if constexpr (Epi::AFTER_DRAIN) E.fused(acc, cur, wr, wc, fr, fq, lds, tid);
#undef PG8_SA
#undef PG8_SB
#undef PG8_STAGE
#undef PG8_LDA
#undef PG8_LDB
#undef PG8_MMA
#undef PG8_WAIT_V
#undef PG8_WAIT_L
#undef PG8_BAR
#undef PG8_SCHED
}
}

__device__ void sample_gemm_resid(const bf16_t* A, int K, const bf16_t* Bt, float* Y, const float* R, float alpha, float sc, unsigned char* smem, int tid) {
    const int wid = __builtin_amdgcn_readfirstlane(tid >> 6), lane = tid & 63, fr = lane & 15, fq = lane >> 4, mbk = wid & 1, kq = wid >> 1;
    f32x4* part = (f32x4*)smem;
    const int Kq = K >> 2;
    for (int t = blockIdx.x; t < 256; t += gridDim.x) {
        const int cbk = 2 * (t & 31) + mbk, row0 = MP + 16 * (t >> 5);
        const bf16_t* ap = A + (size_t)(row0 + fr) * K + kq * Kq + 8 * fq;
        const bf16_t* bp = Bt + (size_t)(16 * cbk + fr) * K + kq * Kq + 8 * fq;
        f32x4 acc0 = (f32x4){0.f, 0.f, 0.f, 0.f}, acc1 = (f32x4){0.f, 0.f, 0.f, 0.f};
#pragma unroll 4
        for (int k = 0; k < Kq; k += 64) {
            const bf16x8 a0 = *(const bf16x8*)(ap + k), b0 = *(const bf16x8*)(bp + k), a1 = *(const bf16x8*)(ap + k + 32), b1 = *(const bf16x8*)(bp + k + 32);
            acc0 = __builtin_amdgcn_mfma_f32_16x16x32_bf16(a0, b0, acc0, 0, 0, 0); acc1 = __builtin_amdgcn_mfma_f32_16x16x32_bf16(a1, b1, acc1, 0, 0, 0);
        }
        __syncthreads();
        part[(kq * 2 + mbk) * 64 + lane] = acc0 + acc1;
        __syncthreads();
        if (kq == 0) {
            const f32x4 sm = (part[mbk * 64 + lane] + part[(2 + mbk) * 64 + lane]) + (part[(4 + mbk) * 64 + lane] + part[(6 + mbk) * 64 + lane]);
#pragma unroll
            for (int j = 0; j < 4; ++j) { const size_t o = (size_t)(row0 + 4 * fq + j) * D + 16 * cbk + fr; Y[o] = alpha * R[o] + sc * sm[j]; }
        }
    }
}

__device__ __forceinline__ void transpose_tile(const float* src, int ld, int col0, int ncv, bf16_t* dst, int K, int r0, int k0, float* tile, int tid) {
#pragma unroll
    for (int e = 0; e < 8; ++e) { const int kk = e * 8 + (tid >> 6), n = tid & 63; tile[kk * 65 + n] = (n < ncv) ? src[(size_t)(k0 + kk) * ld + col0 + n] : 0.f; }
    __syncthreads();
    { const int n = tid >> 3, kq = tid & 7; float v[8];
#pragma unroll
      for (int i = 0; i < 8; ++i) v[i] = tile[(kq * 8 + i) * 65 + n];
      *(u32x4*)(dst + (size_t)(r0 + n) * K + k0 + kq * 8) = pack8(v); }
    __syncthreads();
}
__device__ __forceinline__ int win_col(int r) { return r < 6144 ? r : (r < 8192 ? r + 16 : (r < 8208 ? r - 8192 + 6144 : -1)); }

struct TileJob { const float* src; bf16_t* dst; int ld, col0, ncv, K, r0, k0; };
__device__ __forceinline__ TileJob tile_decode(const Params& p, int t) {
    constexpr int TPL = 6592;
    TileJob j; const int l = t / TPL; int r = t % TPL;
    bf16_t* wt = (bf16_t*)(p.ws + WS_WT) + (size_t)l * LW_END;
    j.ncv = 64;
    if (r < 1408 || (r >= 4480 && r < 5888)) {
        const bool second = r >= 4480; if (second) r -= 4480;
        const int rt = r / 16, kt = r % 16, r0 = rt * 64, pn = r0 / 256, rr = r0 % 256;
        j.src = p.in[second ? (rr < 128 ? 27 : 28) : (rr < 128 ? 8 : 9)] + (size_t)l * D * DFF;
        j.ld = DFF; j.col0 = 128 * pn + (rr & 127); j.dst = wt + (second ? LW_UP2 : LW_UP1); j.K = D; j.r0 = r0; j.k0 = kt * 64;
    } else if ((r >= 1408 && r < 2112) || r >= 5888) {
        const bool second = r >= 5888; r -= second ? 5888 : 1408;
        const int rt = r / 44, kt = r % 44;
        j.src = p.in[second ? 29 : 10] + (size_t)l * DFF * D;
        j.ld = D; j.col0 = rt * 64; j.dst = wt + (second ? LW_DN2 : LW_DN1); j.K = DFF; j.r0 = rt * 64; j.k0 = kt * 64;
    } else if (r < 4224) {
        r -= 2112; const int rt = r / 16, kt = r % 16, r0 = rt * 64;
        if (r0 < 8192) { j.col0 = win_col(r0); } else if (r0 == 8192) { j.col0 = 6144; j.ncv = 16; } else { j.col0 = 0; j.ncv = 0; }
        j.src = p.in[11] + (size_t)l * D * DIN; j.ld = DIN; j.dst = wt + LW_WIN; j.K = D; j.r0 = r0; j.k0 = kt * 64;
    } else {
        r -= 4224; const int rt = r / 16, kt = r % 16;
        j.src = p.in[24] + (size_t)l * D * D; j.ld = D; j.col0 = rt * 64; j.dst = wt + LW_WO; j.K = D; j.r0 = rt * 64; j.k0 = kt * 64;
    }
    return j;
}
__device__ __forceinline__ void tile_load(const TileJob& j, float* v, int tid) {
#pragma unroll
    for (int e = 0; e < 8; ++e) { const int kk = e * 8 + (tid >> 6), n = tid & 63; v[e] = (n < j.ncv) ? j.src[(size_t)(j.k0 + kk) * j.ld + j.col0 + n] : 0.f; }
}
__device__ void phase_prep(const Params& p, unsigned char* smem, const int tid) {
    float* tile = (float*)smem;
    constexpr int NT = 6592 * DEPTH;
    float cur[8], nxt[8];
    int t = blockIdx.x;
    if (t < NT) { const TileJob j = tile_decode(p, t); tile_load(j, cur, tid); }
    for (; t < NT; t += gridDim.x) {
        const int tn = t + gridDim.x;
        if (tn < NT) { const TileJob jn = tile_decode(p, tn); tile_load(jn, nxt, tid); }
        const TileJob j = tile_decode(p, t);
#pragma unroll
        for (int e = 0; e < 8; ++e) tile[(e * 8 + (tid >> 6)) * 65 + (tid & 63)] = cur[e];
        __syncthreads();
        { const int n = tid >> 3, kq = tid & 7; float v[8];
#pragma unroll
          for (int i = 0; i < 8; ++i) v[i] = tile[(kq * 8 + i) * 65 + n];
          *(u32x4*)(j.dst + (size_t)(j.r0 + n) * j.K + j.k0 + kq * 8) = pack8(v); }
        __syncthreads();
#pragma unroll
        for (int e = 0; e < 8; ++e) cur[e] = nxt[e];
    }
    const size_t gt = (size_t)blockIdx.x * 512 + tid, gs = (size_t)gridDim.x * 512;
    float* biasP = (float*)(p.ws + WS_BIASP);
    for (size_t i = gt; i < (size_t)DEPTH * PN; i += gs) { const int l = (int)(i / PN), c = (int)(i % PN), sc = win_col(c); biasP[i] = sc >= 0 ? p.in[12][(size_t)l * DIN + sc] : 0.f; }
    for (size_t i = gt; i < (size_t)DEPTH * 16 * 2 * 4 * 2 * 64; i += gs) {
        const int ln = (int)(i & 63), ks = (int)(i >> 6) & 1, nb = (int)(i >> 7) & 3, gate = (int)(i >> 9) & 1, cb = (int)(i >> 10) & 15, l = (int)(i >> 14);
        const float* w = p.in[gate ? 17 : 15] + ((size_t)l * 16 + cb) * 4096; float v[8];
#pragma unroll
        for (int e = 0; e < 8; ++e) v[e] = w[(32 * ks + 8 * (ln >> 4) + e) * 64 + 16 * nb + (ln & 15)];
        *(u32x4*)(p.ws + WS_RGW + i * 16) = pack8(v);
    }
    float* Xf = (float*)(p.ws + WS_XF); bf16_t* Xb = (bf16_t*)(p.ws + WS_XB); bf16_t* Mg = (bf16_t*)(p.ws + WS_MG);
    for (size_t i = gt; i < (size_t)MPAD * D / 4; i += gs) {
        const size_t e = i * 4; const int row = (int)(e / D);
        f32x4 v = (f32x4){0.f, 0.f, 0.f, 0.f};
        if (row < MP) v = *(const f32x4*)(p.in[0] + e); else if (row < MV) v = *(const f32x4*)(p.in[1] + (e - (size_t)MP * D));
        *(f32x4*)(Xf + e) = v; u32x2 w; w.x = pk2(v[0], v[1]); w.y = pk2(v[2], v[3]); *(u32x2*)(Xb + e) = w;
        if (row >= MV) { u32x2 z; z.x = 0u; z.y = 0u; *(u32x2*)(Mg + e) = z; }
    }
}

__device__ void phase_ln(const float* Y, const float* g, const float* b, float* Xf, bf16_t* Xb, float* out, const int tid) {
    const int lane = tid & 63, gw = blockIdx.x * 8 + (tid >> 6), nw = gridDim.x * 8;
    f32x4 gv[4], bv[4];
#pragma unroll
    for (int i = 0; i < 4; ++i) { gv[i] = *(const f32x4*)(g + i * 256 + lane * 4); bv[i] = *(const f32x4*)(b + i * 256 + lane * 4); }
    for (int row = gw; row < MV; row += nw) {
        f32x4 v[4]; float s = 0.f;
#pragma unroll
        for (int i = 0; i < 4; ++i) { v[i] = *(const f32x4*)(Y + (size_t)row * D + i * 256 + lane * 4); s += (v[i][0] + v[i][1]) + (v[i][2] + v[i][3]); }
        const float mu = wave_sum(s) * (1.0f / D);
        float q = 0.f;
#pragma unroll
        for (int i = 0; i < 4; ++i) { v[i] = v[i] - mu; q += (v[i][0] * v[i][0] + v[i][1] * v[i][1]) + (v[i][2] * v[i][2] + v[i][3] * v[i][3]); }
        const float rstd = rsqrtf(wave_sum(q) * (1.0f / D) + 1e-5f);
#pragma unroll
        for (int i = 0; i < 4; ++i) {
            const f32x4 y = v[i] * rstd * gv[i] + bv[i];
            const size_t o = (size_t)row * D + i * 256 + lane * 4;
            *(f32x4*)(Xf + o) = y; u32x2 w; w.x = pk2(y[0], y[1]); w.y = pk2(y[2], y[3]); *(u32x2*)(Xb + o) = w;
            if (out) *(f32x4*)(out + o) = y;
        }
    }
}

__device__ void ln_rows(const float* Y, const float* g, const float* b, float* Xf, bf16_t* Xb, float* out, int r0, int nrows, const int tid) {
    const int lane = tid & 63, wid = tid >> 6;
    f32x4 gv[4], bv[4];
#pragma unroll
    for (int i = 0; i < 4; ++i) { gv[i] = *(const f32x4*)(g + i * 256 + lane * 4); bv[i] = *(const f32x4*)(b + i * 256 + lane * 4); }
    for (int row = r0 + wid; row < r0 + nrows; row += 8) {
        f32x4 v[4]; float sm = 0.f;
#pragma unroll
        for (int i = 0; i < 4; ++i) { v[i] = *(const f32x4*)(Y + (size_t)row * D + i * 256 + lane * 4); sm += (v[i][0] + v[i][1]) + (v[i][2] + v[i][3]); }
        const float mu = wave_sum(sm) * (1.0f / D);
        float q = 0.f;
#pragma unroll
        for (int i = 0; i < 4; ++i) { v[i] = v[i] - mu; q += (v[i][0] * v[i][0] + v[i][1] * v[i][1]) + (v[i][2] * v[i][2] + v[i][3] * v[i][3]); }
        const float rstd = rsqrtf(wave_sum(q) * (1.0f / D) + 1e-5f);
#pragma unroll
        for (int i = 0; i < 4; ++i) {
            const f32x4 y = v[i] * rstd * gv[i] + bv[i];
            const size_t o = (size_t)row * D + i * 256 + lane * 4;
            *(f32x4*)(Xf + o) = y; u32x2 w; w.x = pk2(y[0], y[1]); w.y = pk2(y[2], y[3]); *(u32x2*)(Xb + o) = w;
            if (out) *(f32x4*)(out + o) = y;
        }
    }
}
__device__ void sample_arrive(const Params& p, const int tid) {
    unsigned* cnt = (unsigned*)(p.ws + WS_BAR) + 64;
    int nt = 0; for (int t = blockIdx.x; t < 256; t += gridDim.x) ++nt;
    asm volatile("s_waitcnt vmcnt(0)" ::: "memory");
    __syncthreads();
    if (tid == 0 && nt) {
        __builtin_amdgcn_fence(__ATOMIC_RELEASE, "agent");
        asm volatile("s_waitcnt vmcnt(0)" ::: "memory");
        __hip_atomic_fetch_add(cnt + 64, (unsigned)nt, __ATOMIC_RELAXED, __HIP_MEMORY_SCOPE_AGENT);
    }
}
__device__ void sample_ln(const Params& p, unsigned gen, const float* Y, const float* g, const float* b, float* Xf, bf16_t* Xb, float* out, const int tid) {
    unsigned* cnt = (unsigned*)(p.ws + WS_BAR) + 64;
    if ((int)blockIdx.x >= DEC) return;
    if (tid == 0) {
        while (__hip_atomic_load(cnt + 64, __ATOMIC_RELAXED, __HIP_MEMORY_SCOPE_AGENT) < 256u * gen) __builtin_amdgcn_s_sleep(10);
        __builtin_amdgcn_fence(__ATOMIC_ACQUIRE, "agent");
        asm volatile("s_waitcnt vmcnt(0)" ::: "memory");
    }
    __syncthreads();
    for (int r = blockIdx.x; r < DEC; r += gridDim.x) ln_rows(Y, g, b, Xf, Xb, out, MP + r, 1, tid);
}

#define MFMA16(a, b, c) __builtin_amdgcn_mfma_f32_16x16x32_bf16((a), (b), (c), 0, 0, 0)

__device__ void rg_prompt(const Params& p, int l, int b, int n, int wid, int lane) {
    const int fr = lane & 15, fq = lane >> 4;
    const bf16_t* P = (const bf16_t*)(p.ws + WS_P);
    bf16_t* OA = (bf16_t*)(p.ws + WS_OA); bf16_t* PA = (bf16_t*)(p.ws + WS_PA);
    float* Atot = (float*)(p.ws + WS_TOT); float* Btot = Atot + (size_t)NB * NCHK * D;
    const float* rcw = p.in[13] + (size_t)l * 4 * D; const float* rcb = p.in[14] + (size_t)l * D;
    const float* wr = p.in[15] + (size_t)l * 16 * 64 * 64; const float* br = p.in[16] + (size_t)l * D;
    const float* wi = p.in[17] + (size_t)l * 16 * 64 * 64; const float* bi = p.in[18] + (size_t)l * D;
    const float* lam = p.in[19] + (size_t)l * D;
    const size_t R0 = (size_t)b * SEQ + 64 * n;
    const unsigned loffT = (unsigned)(fr * PN + 4 * fq), loffTO = (unsigned)(fr * D + 4 * fq), l4 = (unsigned)(4 * fq);
    const unsigned loffA = (unsigned)(fr * PN + 8 * fq), loffD = (unsigned)(4 * fq * PN + fr), loffO = (unsigned)(4 * fq * D + fr), l8 = (unsigned)(8 * fq), lfr = (unsigned)fr;
    for (int cbi = 0; cbi < 2; ++cbi) {
        const int cb = 2 * wid + cbi, ch0 = 64 * cb;
        bf16x8 A[4][2];
#pragma unroll
        for (int ks = 0; ks < 2; ++ks) {
            const int chb = ch0 + 32 * ks;
            f32x4 cw[4][2];
#pragma unroll
            for (int j = 0; j < 4; ++j) { const float* wu = rcw + j * D + chb; cw[j][0] = *(const f32x4*)(wu + l8); cw[j][1] = *(const f32x4*)(wu + 4 + l8); }
            const f32x4 b0 = *(const f32x4*)(rcb + chb + l8), b1 = *(const f32x4*)(rcb + chb + 4 + l8);
#pragma unroll
            for (int m = 0; m < 4; ++m) {
                const int pos = 64 * n + 16 * m + fr;
                float xc[8] = {b0[0], b0[1], b0[2], b0[3], b1[0], b1[1], b1[2], b1[3]};
#pragma unroll
                for (int j = 0; j < 4; ++j) {
                    const bool ok = pos - 3 + j >= 0;
                    const bf16_t* Pu = P + ((long)R0 + 16 * m - 3 + j) * PN + PC_RGX + chb;
                    u32x4 raw = *(const u32x4*)(Pu + loffA); if (!ok) raw = (u32x4){0u, 0u, 0u, 0u};
                    float xv[8]; unpack8(raw, xv);
                    xc[0] += cw[j][0][0] * xv[0]; xc[1] += cw[j][0][1] * xv[1]; xc[2] += cw[j][0][2] * xv[2]; xc[3] += cw[j][0][3] * xv[3];
                    xc[4] += cw[j][1][0] * xv[4]; xc[5] += cw[j][1][1] * xv[5]; xc[6] += cw[j][1][2] * xv[6]; xc[7] += cw[j][1][3] * xv[7];
                }
                const u32x4 pk = pack8(xc); A[m][ks] = *(const bf16x8*)&pk;
                __builtin_amdgcn_sched_barrier(0);
            }
        }
        const bf16x8* fw = (const bf16x8*)(p.ws + WS_RGW) + ((size_t)l * 16 + cb) * 2 * 4 * 2 * 64;
#pragma unroll 1
        for (int nb = 0; nb < 4; ++nb) {
            const bf16x8 Br0 = (fw + (nb * 2 + 0) * 64)[lane], Br1 = (fw + (nb * 2 + 1) * 64)[lane], Bi0 = (fw + (8 + nb * 2 + 0) * 64)[lane], Bi1 = (fw + (8 + nb * 2 + 1) * 64)[lane];
            const int du = ch0 + 16 * nb;
            const f32x4 w0 = *(const f32x4*)(rcw + du + l4), w1 = *(const f32x4*)(rcw + D + du + l4), w2 = *(const f32x4*)(rcw + 2 * D + du + l4), w3 = *(const f32x4*)(rcw + 3 * D + du + l4);
            const f32x4 cbias = *(const f32x4*)(rcb + du + l4), brd = *(const f32x4*)(br + du + l4), bid = *(const f32x4*)(bi + du + l4), lm = *(const f32x4*)(lam + du + l4);
            f32x4 sp; sp[0] = softplusf_(-lm[0]); sp[1] = softplusf_(-lm[1]); sp[2] = softplusf_(-lm[2]); sp[3] = softplusf_(-lm[3]);
            f32x4 CA = (f32x4){1.f, 1.f, 1.f, 1.f}, CB = (f32x4){0.f, 0.f, 0.f, 0.f};
#pragma unroll
            for (int m = 0; m < 4; ++m) {
                f32x4 aR = (f32x4){0.f, 0.f, 0.f, 0.f}, aI = (f32x4){0.f, 0.f, 0.f, 0.f};
                aR = MFMA16(Br0, A[m][0], aR); aR = MFMA16(Br1, A[m][1], aR); aI = MFMA16(Bi0, A[m][0], aI); aI = MFMA16(Bi1, A[m][1], aI);
                const int pos = 64 * n + 16 * m + fr;
                f32x4 xc = cbias;
#pragma unroll
                for (int j = 0; j < 4; ++j) {
                    const bf16_t* Pu = P + ((long)R0 + 16 * m - 3 + j) * PN + PC_RGX + du;
                    u32x2 raw = *(const u32x2*)(Pu + loffT); if (pos - 3 + j < 0) raw = (u32x2){0u, 0u};
                    const f32x4 xv = (f32x4){blo(raw.x), bhi(raw.x), blo(raw.y), bhi(raw.y)};
                    xc += (j == 0 ? w0 : (j == 1 ? w1 : (j == 2 ? w2 : w3))) * xv;
                }
                const bf16_t* Pg = P + (R0 + 16 * m) * PN + du;
                const u32x2 ry = *(const u32x2*)(Pg + PC_RGY + loffT), rg = *(const u32x2*)(Pg + PC_GA + loffT);
                f32x4 av, bv;
#pragma unroll
                for (int e = 0; e < 4; ++e) {
                    const float r = sigmoidf_(aR[e] + brd[e]), ig = sigmoidf_(aI[e] + bid[e]);
                    const float la = -8.0f * r * sp[e];
                    av[e] = __expf(la); bv[e] = __builtin_amdgcn_sqrtf(one_minus_exp(2.0f * la)) * ig * xc[e];
                }
#define RG_SCAN(ctrl) do { _Pragma("unroll") for (int e = 0; e < 4; ++e) { \
                    const float ap = __int_as_float(__builtin_amdgcn_update_dpp(0x3f800000, __float_as_int(av[e]), ctrl, 0xf, 0xf, false)); \
                    const float bp = __int_as_float(__builtin_amdgcn_update_dpp(0, __float_as_int(bv[e]), ctrl, 0xf, 0xf, false)); \
                    bv[e] = av[e] * bp + bv[e]; av[e] = ap * av[e]; } } while (0)
                RG_SCAN(0x111); RG_SCAN(0x112); RG_SCAN(0x114); RG_SCAN(0x118);
#undef RG_SCAN
                f32x4 Fa, Fb;
#pragma unroll
                for (int e = 0; e < 4; ++e) { Fa[e] = __shfl(av[e], (lane & 48) | 15); Fb[e] = __shfl(bv[e], (lane & 48) | 15); }
                const float gy[4] = {blo(ry.x), bhi(ry.x), blo(ry.y), bhi(ry.y)}, gg[4] = {blo(rg.x), bhi(rg.x), blo(rg.y), bhi(rg.y)};
                float oa[4], pa[4];
#pragma unroll
                for (int e = 0; e < 4; ++e) {
                    const float Aj = CA[e] * av[e], Bj = av[e] * CB[e] + bv[e];
                    const float gm = geluf_(gy[e]) * sigmoidf_(gg[e]);
                    oa[e] = Bj * gm; pa[e] = Aj * gm;
                }
                const size_t oo = (R0 + 16 * m) * D + du;
                { u32x2 wv; wv.x = pk2(oa[0], oa[1]); wv.y = pk2(oa[2], oa[3]); *(u32x2*)(OA + oo + loffTO) = wv; wv.x = pk2(pa[0], pa[1]); wv.y = pk2(pa[2], pa[3]); *(u32x2*)(PA + oo + loffTO) = wv; }
                const f32x4 nCa = CA * Fa, nCb = Fa * CB + Fb; CA = nCa; CB = nCb;
                __builtin_amdgcn_sched_barrier(0);
            }
            if (fr == 0) { const size_t o = ((size_t)b * NCHK + n) * D + du; *(f32x4*)(Atot + o + l4) = CA; *(f32x4*)(Btot + o + l4) = CB; }
        }
    }
}

constexpr int LQ = 136;
constexpr int GRP_BYTES = 63488;
static_assert(2 * GRP_BYTES <= LDS_BYTES, "lds");

__device__ void gdn_prep(const Params& p, int l, int b, int n, unsigned char* smem, int tid) {
    const int g = __builtin_amdgcn_readfirstlane(tid >> 8), gt = tid & 255, gw = __builtin_amdgcn_readfirstlane((tid >> 6) & 3), lane = tid & 63, fr = lane & 15, fq = lane >> 4;
    unsigned goff = (unsigned)g * GRP_BYTES; asm volatile("v_mov_b32 %0, %0" : "+v"(goff));
    LAS unsigned char* base = (LAS unsigned char*)smem + goff;
    LAS bf16_t* qn = (LAS bf16_t*)base; LAS bf16_t* kn = qn + 64 * LQ; LAS bf16_t* vv = kn + 64 * LQ;
    LAS bf16_t* Lb = (LAS bf16_t*)(base + 53248); LAS float* gcs = (LAS float*)(base + 62464);
    LAS bf16_t* XT = (LAS bf16_t*)base; LAS float* Ub = (LAS float*)(base + 36864);
    asm volatile("" : "+v"(kn)); asm volatile("" : "+v"(vv)); asm volatile("" : "+v"(Lb)); asm volatile("" : "+v"(gcs)); asm volatile("" : "+v"(Ub));
    LAS float* bts = gcs + 64; LAS float* qs = gcs + 128; LAS float* ks = gcs + 192;
    const bf16_t* P_ = (const bf16_t*)(p.ws + WS_P);
    unsigned char* prep = p.ws + WS_PREP;
    bf16_t* QD_ = (bf16_t*)(prep + PR_QD); bf16_t* KT_ = (bf16_t*)(prep + PR_KT); bf16_t* WQ_ = (bf16_t*)(prep + PR_WQ);
    float* UU_ = (float*)(prep + PR_UU); bf16_t* AI_ = (bf16_t*)(prep + PR_AI); float* GL_ = (float*)(prep + PR_GL);
    const float* gcw_ = p.in[20] + (size_t)l * 4 * CCH;
    const size_t R0 = (size_t)b * SEQ + 64 * n;
    const unsigned loP = (unsigned)((lane >> 2) * PN + 32 * (lane & 3)), loW = (unsigned)(32 * (lane & 3)), loAI = (unsigned)(256 * fq + fr);
    const unsigned loQD = (unsigned)((lane >> 2) * 128 + (lane & 3) * 32), loKT = (unsigned)((lane >> 1) * 64 + (lane & 1) * 32), loL = (unsigned)lane, loLP = (unsigned)(lane * PN);
    const unsigned loW2 = (unsigned)(8 * (lane & 15)), loP2 = (unsigned)((lane >> 4) * 16 * PN + 8 * (lane & 15));
#pragma unroll 1
    for (int pr = 0; pr < 4; ++pr) {
        int zero; asm volatile("s_mov_b32 %0, 0" : "=s"(zero));
        const bf16_t* P = P_ + zero; bf16_t* QD = QD_ + zero; bf16_t* KT = KT_ + zero; bf16_t* WQ = WQ_ + zero; float* UU = UU_ + zero; bf16_t* AI = AI_ + zero; float* GL = GL_ + zero;
        const float* gcw = gcw_ + zero;
        const int h = 2 * pr + g;
        const size_t ci = ((size_t)b * NH + h) * NCHK + n;
#ifndef NO_S1
        if (gw < 3) {
            const int X = gw, tr = lane >> 4, cg = lane & 15, t0 = 16 * tr;
            const float* wu = gcw + X * 1024 + 128 * h;
            f32x4 w[4][2];
#pragma unroll
            for (int j = 0; j < 4; ++j) { w[j][0] = *(const f32x4*)(wu + j * CCH + loW2); w[j][1] = *(const f32x4*)(wu + j * CCH + 4 + loW2); }
            const bf16_t* Pu = P + ((long)R0 - 3) * PN + PC_Q + X * 1024 + 128 * h;
            LAS bf16_t* dst = (X == 0 ? qn : (X == 1 ? kn : vv)) + t0 * LQ + 8 * cg;
            float ssum[16];
            float acc[4][8];
#pragma unroll
            for (int hf = 0; hf < 2; ++hf) {
                u32x4 raw[10];
#pragma unroll
                for (int rr = 0; rr < 10; ++rr) { const int r = 10 * hf + rr; if (r < 19) { raw[rr] = *(const u32x4*)(Pu + (long)r * PN + loP2); if (64 * n + t0 + r - 3 < 0) raw[rr] = (u32x4){0u, 0u, 0u, 0u}; } }
#pragma unroll
                for (int rr = 0; rr < 10; ++rr) {
                    const int r = 10 * hf + rr;
                    if (r < 19) {
                        float xv[8]; unpack8(raw[rr], xv);
#pragma unroll
                        for (int j = 0; j < 4; ++j) {
                            const int i = r - j;
                            if (i >= 0 && i < 16) {
                                const int sl = i & 3;
                                if (j == 0) {
#pragma unroll
                                    for (int e = 0; e < 8; ++e) acc[sl][e] = w[0][e >> 2][e & 3] * xv[e];
                                } else {
#pragma unroll
                                    for (int e = 0; e < 8; ++e) acc[sl][e] += w[j][e >> 2][e & 3] * xv[e];
                                }
                            }
                        }
                        if (r >= 3) {
                            const int i = r - 3, sl = i & 3;
                            float o8[8]; float sq_ = 0.f;
#pragma unroll
                            for (int e = 0; e < 8; ++e) { o8[e] = siluf_(acc[sl][e]); sq_ += o8[e] * o8[e]; }
                            ssum[i] = sq_;
                            *(LAS u32x4*)(dst + i * LQ) = pack8(o8);
                            asm volatile("" : "+v"(ssum[i]));
                        }
                    }
                }
                __builtin_amdgcn_sched_barrier(0);
            }
            if (X < 2) {
                float mine = 0.f;
#pragma unroll
                for (int i = 0; i < 16; ++i) { float v_ = ssum[i]; v_ += __shfl_xor(v_, 1); v_ += __shfl_xor(v_, 2); v_ += __shfl_xor(v_, 4); v_ += __shfl_xor(v_, 8); if (cg == i) mine = v_; }
                (X == 0 ? qs : ks)[t0 + cg] = rsqrtf(mine + 1e-6f) * (X == 0 ? 0.08838834764831845f : 1.0f);
            }
        } else {
            const bf16_t* Pg = P + R0 * PN + PC_A + h;
            const float ga = bf2f(Pg[loLP]), gb = bf2f((Pg + 8)[loLP]);
            const float beta = sigmoidf_(gb);
            float gv = -__expf(p.in[21][l * NH + h]) * softplusf_(ga + p.in[22][l * NH + h]);
#pragma unroll
            for (int off = 1; off < 64; off <<= 1) { const float o = __shfl_up(gv, off); if (lane >= off) gv += o; }
            gcs[lane] = gv; bts[lane] = beta;
        }
        __syncthreads();
#endif
#ifndef NO_S2
        { f32x4 aKK[4], aQK[4];
#pragma unroll
          for (int nb = 0; nb < 4; ++nb) { aKK[nb] = (f32x4){0.f, 0.f, 0.f, 0.f}; aQK[nb] = (f32x4){0.f, 0.f, 0.f, 0.f}; }
#pragma unroll
          for (int ks = 0; ks < 4; ++ks) {
              const bf16x8 Ak = *(const LAS bf16x8*)(kn + (16 * gw + fr) * LQ + 32 * ks + 8 * fq), Aq = *(const LAS bf16x8*)(qn + (16 * gw + fr) * LQ + 32 * ks + 8 * fq);
#pragma unroll
              for (int nb = 0; nb < 4; ++nb) { const bf16x8 Bk = *(const LAS bf16x8*)(kn + (16 * nb + fr) * LQ + 32 * ks + 8 * fq); aKK[nb] = MFMA16(Ak, Bk, aKK[nb]); aQK[nb] = MFMA16(Aq, Bk, aQK[nb]); }
          }
#pragma unroll
          for (int nb = 0; nb < 4; ++nb) {
              const int sx = 16 * nb + fr; const float gs = gcs[sx], kss = ks[sx];
#pragma unroll
              for (int j = 0; j < 4; ++j) {
                  const int c = 16 * gw + 4 * fq + j; const float dec = __expf(fminf(gcs[c] - gs, 0.f));
                  Lb[c * 72 + sx] = f2bf((c > sx) ? bts[c] * ks[c] * kss * aKK[nb][j] * dec : 0.f);
                  (AI + ci * 4096 + (16 * gw + j) * 64 + 16 * nb)[loAI] = f2bf((c >= sx) ? qs[c] * kss * aQK[nb][j] * dec : 0.f);
              }
          } }
#endif
#ifndef NO_S4
        { const int t = gt >> 2, part = gt & 3; const float e = __expf(gcs[t]) * qs[t];
#pragma unroll
          for (int c4 = 0; c4 < 4; ++c4) { const u32x4 raw = *(const LAS u32x4*)(qn + t * LQ + 32 * part + 8 * c4); float v[8]; unpack8(raw, v);
#pragma unroll
              for (int i = 0; i < 8; ++i) v[i] *= e;
              *(u32x4*)(QD + ci * 8192 + 16 * gw * 128 + 8 * c4 + loQD) = pack8(v); }
          const int kd = gt >> 1, half = gt & 1; const float glast = gcs[63];
#pragma unroll
          for (int c4 = 0; c4 < 4; ++c4) { float v[8];
#pragma unroll
              for (int i = 0; i < 8; ++i) { const int tt = 32 * half + 8 * c4 + i; v[i] = bf2f(kn[tt * LQ + kd]) * ks[tt] * __expf(glast - gcs[tt]); }
              *(u32x4*)(KT + ci * 8192 + 32 * gw * 64 + 8 * c4 + loKT) = pack8(v); }
          if (gt == 0) GL[ci] = __expf(glast); }
#endif
#ifndef NO_S3
        { float x[64];
          if (gt < 128) {
#pragma unroll
              for (int t = 0; t < 64; ++t) { x[t] = bf2f(vv[t * LQ + gt]) * bts[t]; if ((t & 7) == 7) __builtin_amdgcn_sched_barrier(0); }
          } else {
#pragma unroll
              for (int t = 0; t < 64; ++t) { x[t] = bf2f(kn[t * LQ + gt - 128]) * bts[t] * ks[t] * __expf(gcs[t]); if ((t & 7) == 7) __builtin_amdgcn_sched_barrier(0); }
          }
          __syncthreads();
          LAS bf16_t* xrow = XT + gt * 72;
          LAS float* ucol = Ub + 64 * gw + lane;
#pragma unroll
          for (int bi = 0; bi < 4; ++bi) {
              if (bi > 0) {
                  f32x4 acc[4];
#pragma unroll
                  for (int q = 0; q < 4; ++q) acc[q] = (f32x4){0.f, 0.f, 0.f, 0.f};
#pragma unroll
                  for (int ks = 0; ks < (bi == 3 ? 2 : 1); ++ks) {
                      bf16x8 Af = *(const LAS bf16x8*)(Lb + (16 * bi + fr) * 72 + 32 * ks + 8 * fq);
                      if (32 * ks + 8 * fq >= 16 * bi) Af = (bf16x8){0, 0, 0, 0, 0, 0, 0, 0};
#pragma unroll
                      for (int q = 0; q < 4; ++q) { const bf16x8 Bf = *(const LAS bf16x8*)(XT + (64 * gw + 16 * q + fr) * 72 + 32 * ks + 8 * fq); acc[q] = MFMA16(Af, Bf, acc[q]); }
                  }
#pragma unroll
                  for (int q = 0; q < 4; ++q)
#pragma unroll
                      for (int j = 0; j < 4; ++j) Ub[(4 * fq + j) * 256 + 64 * gw + 16 * q + fr] = acc[q][j];
                  asm volatile("s_waitcnt lgkmcnt(0)" ::: "memory");
#pragma unroll
                  for (int i = 0; i < 16; ++i) x[16 * bi + i] -= ucol[i * 256];
                  __builtin_amdgcn_sched_barrier(0);
              }
#pragma unroll
              for (int i = 1; i < 16; ++i) {
                  float lv[16];
                  unpack8(*(const LAS u32x4*)(Lb + (16 * bi + i) * 72 + 16 * bi), lv);
                  if (i > 8) unpack8(*(const LAS u32x4*)(Lb + (16 * bi + i) * 72 + 16 * bi + 8), lv + 8);
#pragma unroll
                  for (int j = 0; j < i; ++j) x[16 * bi + i] -= lv[j] * x[16 * bi + j];
                  asm volatile("" : "+v"(x[16 * bi + i]));
              }
              if (bi < 3) {
                  *(LAS u32x4*)(xrow + 16 * bi) = pack8(x + 16 * bi); *(LAS u32x4*)(xrow + 16 * bi + 8) = pack8(x + 16 * bi + 8);
                  asm volatile("s_waitcnt lgkmcnt(0)" ::: "memory");
              }
          }
          if (gt < 128) {
#pragma unroll
              for (int t = 0; t < 64; ++t) (UU + ci * 8192 + t * 128 + 64 * gw)[loL] = x[t];
          } else {
#pragma unroll
              for (int t = 0; t < 64; ++t) (WQ + ci * 8192 + t * 128 + 64 * (gw - 2))[loL] = f2bf(x[t]);
          } }
#endif
        __syncthreads();
    }
}

__device__ void phase_m1(const Params& p, int l, unsigned char* smem, const int tid, const int dbl) {
    const int wid = __builtin_amdgcn_readfirstlane(tid >> 6), lane = tid & 63;
#ifndef NO_RG
    for (int rep = 0; rep < ((dbl >> 13) & 1) + 1; ++rep)
    for (int u = blockIdx.x; u < NB * NCHK; u += gridDim.x) rg_prompt(p, l, u / NCHK, u % NCHK, wid, lane);
#endif
    __builtin_amdgcn_sched_barrier(0);
#ifndef NO_GDN
    for (int rep = 0; rep < ((dbl >> 14) & 1) + 1; ++rep)
    for (int u = blockIdx.x; u < NB * NCHK; u += gridDim.x) gdn_prep(p, l, u / NCHK, u % NCHK, smem, tid);
#endif
}

#define LBAR() do { asm volatile("s_waitcnt lgkmcnt(0)" ::: "memory"); __builtin_amdgcn_s_barrier(); asm volatile("" ::: "memory"); } while (0)
__device__ void phase_m2(const Params& p, int l, unsigned char* smem, const int tid) {
    const int wid = __builtin_amdgcn_readfirstlane(tid >> 6), lane = tid & 63, fr = lane & 15, fq = lane >> 4;
    bf16_t* St = (bf16_t*)smem;
    bf16_t* Vt = St + 32 * LQ;
    unsigned char* prep = p.ws + WS_PREP;
    const bf16_t* QD = (const bf16_t*)(prep + PR_QD); const bf16_t* KT = (const bf16_t*)(prep + PR_KT); const bf16_t* WQ = (const bf16_t*)(prep + PR_WQ);
    const float* UU = (const float*)(prep + PR_UU); const bf16_t* AI = (const bf16_t*)(prep + PR_AI); const float* GL = (const float*)(prep + PR_GL);
    float* Ob = (float*)(p.ws + WS_O);
    const int mb = wid & 3, role = wid >> 2;
    for (int chn = blockIdx.x; chn < NB * NH * 4; chn += gridDim.x) {
        const int xcd = chn & 7, idx = chn >> 3, sl = idx & 3, bh = xcd * 8 + (idx >> 2), b = bh >> 3, h = bh & 7;
        f32x4 Sacc[2];
        Sacc[0] = (f32x4){0.f, 0.f, 0.f, 0.f}; Sacc[1] = (f32x4){0.f, 0.f, 0.f, 0.f};
        __syncthreads();
        for (int i = tid; i < 32 * LQ / 2; i += 512) ((unsigned*)St)[i] = 0u;
        __syncthreads();
        bf16x8 Af[4], Kf[2], Gf[2]; float eg; float uv[2][4];
#define M2_LOAD(AF, KF, GF, EG, UV, nn) do { const size_t ci_ = (size_t)bh * NCHK + (nn); \
            const bf16_t* Asrc_ = (role == 0 ? WQ : QD) + ci_ * 8192 + (16 * mb + fr) * 128 + 8 * fq; \
            _Pragma("unroll") for (int ks = 0; ks < 4; ++ks) AF[ks] = *(const bf16x8*)(Asrc_ + 32 * ks); \
            _Pragma("unroll") for (int ks = 0; ks < 2; ++ks) { KF[ks] = *(const bf16x8*)(KT + ci_ * 8192 + (16 * wid + fr) * 64 + 32 * ks + 8 * fq); GF[ks] = *(const bf16x8*)(AI + ci_ * 4096 + (16 * mb + fr) * 64 + 32 * ks + 8 * fq); } \
            EG = GL[ci_]; \
            _Pragma("unroll") for (int nb = 0; nb < 2; ++nb) _Pragma("unroll") for (int j = 0; j < 4; ++j) UV[nb][j] = UU[ci_ * 8192 + (16 * mb + 4 * fq + j) * 128 + 32 * sl + 16 * nb + fr]; } while (0)
        M2_LOAD(Af, Kf, Gf, eg, uv, 0);
#pragma unroll 1
        for (int n = 0; n < NCHK; ++n) {
            bf16x8 Afn[4], Kfn[2], Gfn[2]; float egn; float uvn[2][4];
            { const int nn = n + 1 < NCHK ? n + 1 : n; M2_LOAD(Afn, Kfn, Gfn, egn, uvn, nn); }
            f32x4 acc[2]; acc[0] = (f32x4){0.f, 0.f, 0.f, 0.f}; acc[1] = (f32x4){0.f, 0.f, 0.f, 0.f};
#pragma unroll
            for (int ks = 0; ks < 4; ++ks)
#pragma unroll
                for (int nb = 0; nb < 2; ++nb) { const bf16x8 Bf = *(const bf16x8*)(St + (16 * nb + fr) * LQ + 32 * ks + 8 * fq); acc[nb] = MFMA16(Af[ks], Bf, acc[nb]); }
            if (role == 0) {
#pragma unroll
                for (int nb = 0; nb < 2; ++nb) { u32x2 w; w.x = pk2(uv[nb][0] - acc[nb][0], uv[nb][1] - acc[nb][1]); w.y = pk2(uv[nb][2] - acc[nb][2], uv[nb][3] - acc[nb][3]);
                    *(u32x2*)(Vt + (16 * nb + fr) * 72 + 16 * mb + 4 * fq) = w; }
            }
            LBAR();
            bf16x8 Vf[2][2];
#pragma unroll
            for (int ks = 0; ks < 2; ++ks)
#pragma unroll
                for (int nb = 0; nb < 2; ++nb) Vf[ks][nb] = *(const bf16x8*)(Vt + (16 * nb + fr) * 72 + 32 * ks + 8 * fq);
            if (role == 1) {
#pragma unroll
                for (int ks = 0; ks < 2; ++ks)
#pragma unroll
                    for (int nb = 0; nb < 2; ++nb) acc[nb] = MFMA16(Gf[ks], Vf[ks][nb], acc[nb]);
#pragma unroll
                for (int nb = 0; nb < 2; ++nb)
#pragma unroll
                    for (int j = 0; j < 4; ++j) Ob[((size_t)b * SEQ + 64 * n + 16 * mb + 4 * fq + j) * D + 128 * h + 32 * sl + 16 * nb + fr] = acc[nb][j];
            }
            Sacc[0] = Sacc[0] * eg; Sacc[1] = Sacc[1] * eg;
#pragma unroll
            for (int ks = 0; ks < 2; ++ks)
#pragma unroll
                for (int nb = 0; nb < 2; ++nb) Sacc[nb] = MFMA16(Kf[ks], Vf[ks][nb], Sacc[nb]);
#pragma unroll
            for (int nb = 0; nb < 2; ++nb) { u32x2 w; w.x = pk2(Sacc[nb][0], Sacc[nb][1]); w.y = pk2(Sacc[nb][2], Sacc[nb][3]); *(u32x2*)(St + (16 * nb + fr) * LQ + 16 * wid + 4 * fq) = w; }
            LBAR();
#pragma unroll
            for (int ks = 0; ks < 4; ++ks) Af[ks] = Afn[ks];
#pragma unroll
            for (int ks = 0; ks < 2; ++ks) { Kf[ks] = Kfn[ks]; Gf[ks] = Gfn[ks]; }
            eg = egn;
#pragma unroll
            for (int nb = 0; nb < 2; ++nb)
#pragma unroll
                for (int j = 0; j < 4; ++j) uv[nb][j] = uvn[nb][j];
        }
#undef M2_LOAD
        float* So = p.out + O_PS + (((size_t)l * NB + b) * NH + h) * 128 * 128;
#pragma unroll
        for (int nb = 0; nb < 2; ++nb)
#pragma unroll
            for (int j = 0; j < 4; ++j) So[(16 * wid + 4 * fq + j) * 128 + 32 * sl + 16 * nb + fr] = Sacc[nb][j];
    }
}

__device__ void m3_prompt(const Params& p, int l, int b, int n, unsigned char* smem, int tid) {
    const int wid = __builtin_amdgcn_readfirstlane(tid >> 6), lane = tid & 63;
    float* hin = (float*)smem;
    const float* Atot = (const float*)(p.ws + WS_TOT); const float* Btot = Atot + (size_t)NB * NCHK * D;
    const bf16_t* P = (const bf16_t*)(p.ws + WS_P);
    const bf16_t* OA = (const bf16_t*)(p.ws + WS_OA); const bf16_t* PA = (const bf16_t*)(p.ws + WS_PA);
    const float* Ob = (const float*)(p.ws + WS_O); bf16_t* Mg = (bf16_t*)(p.ws + WS_MG);
    __syncthreads();
    for (int c = tid; c < D; c += 512) {
        float hv = 0.f;
        for (int i0 = 0; i0 < n; i0 += 8) {
            float av[8], bv[8];
#pragma unroll
            for (int e = 0; e < 8; ++e) { const bool ok = i0 + e < n; const size_t o = ((size_t)b * NCHK + (ok ? i0 + e : 0)) * D + c; const float a_ = Atot[o], b_ = Btot[o]; av[e] = ok ? a_ : 1.f; bv[e] = ok ? b_ : 0.f; }
#pragma unroll
            for (int e = 0; e < 8; ++e) hv = av[e] * hv + bv[e];
        }
        hin[c] = hv;
        if (n == NCHK - 1) { const size_t o = ((size_t)b * NCHK + n) * D + c; p.out[O_PH + ((size_t)l * NB + b) * D + c] = Atot[o] * hv + Btot[o]; }
    }
    __syncthreads();
    const float* nw = p.in[23] + (size_t)l * 128;
    const int c0 = 16 * lane;
    float nwv[16], hv[16];
#pragma unroll
    for (int i = 0; i < 16; ++i) { nwv[i] = nw[(c0 + i) & 127]; hv[i] = hin[c0 + i]; }
    for (int rr = wid; rr < 64; rr += 8) {
        const size_t R = (size_t)b * SEQ + 64 * n + rr;
        float o[16], oa[16], pa[16], z[16], gb[16];
#pragma unroll
        for (int q = 0; q < 4; ++q) { const f32x4 v = *(const f32x4*)(Ob + R * D + c0 + 4 * q); o[4 * q] = v[0]; o[4 * q + 1] = v[1]; o[4 * q + 2] = v[2]; o[4 * q + 3] = v[3]; }
#pragma unroll
        for (int q = 0; q < 2; ++q) {
            unpack8(*(const u32x4*)(OA + R * D + c0 + 8 * q), oa + 8 * q); unpack8(*(const u32x4*)(PA + R * D + c0 + 8 * q), pa + 8 * q);
            unpack8(*(const u32x4*)(P + R * PN + PC_Z + c0 + 8 * q), z + 8 * q); unpack8(*(const u32x4*)(P + R * PN + PC_GB + c0 + 8 * q), gb + 8 * q);
        }
        float ss = 0.f;
#pragma unroll
        for (int i = 0; i < 16; ++i) ss += o[i] * o[i];
        ss += __shfl_xor(ss, 1); ss += __shfl_xor(ss, 2); ss += __shfl_xor(ss, 4);
        const float rstd = rsqrtf(ss * (1.0f / 128.0f) + 1e-6f);
        float mg[16];
#pragma unroll
        for (int i = 0; i < 16; ++i) mg[i] = oa[i] + pa[i] * hv[i] + sigmoidf_(gb[i]) * (o[i] * rstd * nwv[i] * siluf_(z[i]));
        *(u32x4*)(Mg + R * D + c0) = pack8(mg); *(u32x4*)(Mg + R * D + c0 + 8) = pack8(mg + 8);
    }
    if (n == NCHK - 1) {
        for (int i = tid; i < 3 * D; i += 512) { const int j = i / D, c = i % D; p.out[O_PRC + (((size_t)l * NB + b) * 3 + j) * D + c] = bf2f(P[((size_t)b * SEQ + SEQ - 3 + j) * PN + PC_RGX + c]); }
        for (int i = tid; i < 3 * CCH; i += 512) { const int j = i / CCH, c = i % CCH; p.out[O_PGC + (((size_t)l * NB + b) * 3 + j) * CCH + c] = bf2f(P[((size_t)b * SEQ + SEQ - 3 + j) * PN + PC_Q + c]); }
    }
}

__device__ void m3_sample(const Params& p, int l, int bs, int h, unsigned char* smem, int tid) {
    float* sq = (float*)smem;
    float* sxc = sq + 384;
    float* red = sxc + 128;
    float* part = red + 16;
    const bf16_t* P = (const bf16_t*)(p.ws + WS_P);
    bf16_t* Mg = (bf16_t*)(p.ws + WS_MG);
    const size_t R = (size_t)MP + bs;
    const int wid = __builtin_amdgcn_readfirstlane(tid >> 6), lane = tid & 63;
    const int kq = tid >> 7, v = tid & 127;
    const int d = 128 * h + v, blk = d >> 6, dd = d & 63, xb = (v >> 6) * 64;
    const float* S0 = p.in[4] + ((((size_t)l * DEC + bs) * NH + h) * 128 + 32 * kq) * 128 + v;
    float s0[32], wr16[16], wi16[16];
#pragma unroll
    for (int i = 0; i < 32; ++i) s0[i] = __builtin_nontemporal_load(S0 + (size_t)i * 128);
    { const float* wr = p.in[15] + (((size_t)l * 16 + blk) * 64 + 16 * kq) * 64 + dd; const float* wi = p.in[17] + (((size_t)l * 16 + blk) * 64 + 16 * kq) * 64 + dd;
#pragma unroll
      for (int c = 0; c < 16; ++c) { wr16[c] = wr[c * 64]; wi16[c] = wi[c * 64]; } }
    __syncthreads();
    if (tid < 384) {
        const int X = tid >> 7, i = tid & 127, chp = X * 1024 + 128 * h + i;
        const float cur = bf2f(P[R * PN + PC_Q + chp]);
        const float* hist = p.in[5] + (((size_t)l * DEC + bs) * 3) * CCH + chp;
        const float h0 = hist[0], h1 = hist[CCH], h2 = hist[2 * CCH];
        const float* w = p.in[20] + (size_t)l * 4 * CCH + chp;
        sq[tid] = siluf_(w[0] * h0 + w[CCH] * h1 + w[2 * CCH] * h2 + w[3 * CCH] * cur);
        float* so = p.out + O_SGC + (((size_t)l * DEC + bs) * 3) * CCH + chp;
        so[0] = h1; so[CCH] = h2; so[2 * CCH] = cur;
    } else {
        const int dch = 128 * h + (tid - 384);
        const float cur = bf2f(P[R * PN + PC_RGX + dch]);
        const float* hist = p.in[3] + (((size_t)l * DEC + bs) * 3) * D + dch;
        const float h0 = hist[0], h1 = hist[D], h2 = hist[2 * D];
        const float* w = p.in[13] + (size_t)l * 4 * D + dch;
        sxc[tid - 384] = w[0] * h0 + w[D] * h1 + w[2 * D] * h2 + w[3 * D] * cur + p.in[14][(size_t)l * D + dch];
        float* so = p.out + O_SRC + (((size_t)l * DEC + bs) * 3) * D + dch;
        so[0] = h1; so[D] = h2; so[2 * D] = cur;
    }
    __syncthreads();
    if (wid < 3) {
        const float a0 = wid == 1 ? sq[128 + lane] : sq[lane], a1 = wid == 1 ? sq[192 + lane] : sq[64 + lane];
        const float b0 = wid == 0 ? a0 : sq[128 + lane], b1 = wid == 0 ? a1 : sq[192 + lane];
        const float sm = wave_sum(a0 * b0 + a1 * b1);
        if (lane == 0) red[wid] = sm;
    }
    { float kS = 0.f, qS = 0.f, rp = 0.f, ip = 0.f;
#pragma unroll
      for (int i = 0; i < 32; ++i) { kS += sq[128 + 32 * kq + i] * s0[i]; qS += sq[32 * kq + i] * s0[i]; }
#pragma unroll
      for (int c = 0; c < 16; ++c) { const float x = sxc[xb + 16 * kq + c]; rp += x * wr16[c]; ip += x * wi16[c]; }
      part[kq * 128 + v] = kS; part[512 + kq * 128 + v] = qS; part[1024 + kq * 128 + v] = rp; part[1536 + kq * 128 + v] = ip; }
    __syncthreads();
    const float qsc = rsqrtf(red[0] + 1e-6f) * 0.08838834764831845f, ksc = rsqrtf(red[1] + 1e-6f);
    const float qk = red[2] * qsc * ksc;
    const float ga = bf2f(P[R * PN + PC_A + h]), gb_ = bf2f(P[R * PN + PC_B + h]);
    const float beta = sigmoidf_(gb_);
    const float eg = __expf(-__expf(p.in[21][l * NH + h]) * softplusf_(ga + p.in[22][l * NH + h]));
    const float kSt = (part[v] + part[128 + v] + part[256 + v] + part[384 + v]) * ksc;
    const float qSt = (part[512 + v] + part[640 + v] + part[768 + v] + part[896 + v]) * qsc;
    const float vnew = beta * (sq[256 + v] - eg * kSt);
    const float o = eg * qSt + qk * vnew;
    float* S1 = p.out + O_SS + ((((size_t)l * DEC + bs) * NH + h) * 128 + 32 * kq) * 128 + v;
#pragma unroll
    for (int i = 0; i < 32; ++i) __builtin_nontemporal_store(s0[i] * eg + sq[128 + 32 * kq + i] * ksc * vnew, S1 + (size_t)i * 128);
    if (wid < 2) { const float sm = wave_sum(o * o); if (lane == 0) red[4 + wid] = sm; }
    __syncthreads();
    if (tid < 128) {
        const float rstd = rsqrtf((red[4] + red[5]) * (1.0f / 128.0f) + 1e-6f);
        const float rp = p.in[16][(size_t)l * D + d] + part[1024 + v] + part[1152 + v] + part[1280 + v] + part[1408 + v];
        const float ip = p.in[18][(size_t)l * D + d] + part[1536 + v] + part[1664 + v] + part[1792 + v] + part[1920 + v];
        const float r = sigmoidf_(rp), ig = sigmoidf_(ip);
        const float la = -8.0f * r * softplusf_(-p.in[19][(size_t)l * D + d]);
        const float a = __expf(la);
        const float hnew = a * p.in[2][((size_t)l * DEC + bs) * D + d] + __builtin_amdgcn_sqrtf(one_minus_exp(2.0f * la)) * (ig * sxc[v]);
        p.out[O_SH + ((size_t)l * DEC + bs) * D + d] = hnew;
        const float outa = hnew * geluf_(bf2f(P[R * PN + PC_RGY + d]));
        const float outb = o * rstd * p.in[23][(size_t)l * 128 + v] * siluf_(bf2f(P[R * PN + PC_Z + d]));
        Mg[R * D + d] = f2bf(sigmoidf_(bf2f(P[R * PN + PC_GA + d])) * outa + sigmoidf_(bf2f(P[R * PN + PC_GB + d])) * outb);
    }
}

__device__ void phase_m3(const Params& p, int l, unsigned char* smem, const int tid) {
    const int NU = NB * NCHK + DEC * NH;
    for (int u = blockIdx.x; u < NU; u += gridDim.x) {
        if (u < NB * NCHK) m3_prompt(p, l, u / NCHK, u % NCHK, smem, tid);
        else { const int s = u - NB * NCHK; m3_sample(p, l, s >> 3, s & 7, smem, tid); }
    }
}

constexpr int PPL = 9;
constexpr int NPH = 1 + PPL * DEPTH;
__global__ void __launch_bounds__(512) mega(Params p, int ph_lo, int ph_hi, int dbl) {
    extern __shared__ __attribute__((aligned(16))) unsigned char smem[];
    LAS unsigned char* lds = (LAS unsigned char*)smem;
    bf16_t* WT = (bf16_t*)(p.ws + WS_WT);
    float* Xf = (float*)(p.ws + WS_XF); bf16_t* Xb = (bf16_t*)(p.ws + WS_XB);
    bf16_t* Pb = (bf16_t*)(p.ws + WS_P); bf16_t* Hb = Pb; bf16_t* Mg = (bf16_t*)(p.ws + WS_MG);
    float* Ypre = (float*)(p.ws + WS_PREP);
    for (int ph = ph_lo; ph < ph_hi; ++ph) {
        if (ph > ph_lo) {
            if (ph_hi < 0) cg::this_grid().sync();
            grid_barrier((unsigned*)(p.ws + WS_BAR), (unsigned)ph * gridDim.x);
        }
        const int reps = ((dbl >> (ph == 0 ? 12 : (ph - 1) % PPL)) & 1) + 1;
        for (int rep = 0; rep < reps; ++rep) {
        int tid; asm volatile("v_mov_b32 %0, %1" : "=v"(tid) : "v"((int)threadIdx.x));
        if (ph == 0) { phase_prep(p, smem, tid); continue; }
        const int l = (ph - 1) / PPL, s = (ph - 1) % PPL;
        const bf16_t* wt = WT + (size_t)l * LW_END;
        pg8::StaticOrder S;
#ifdef ONLY_M1
        if (s == 3) phase_m1(p, l, smem, tid, dbl);
        continue;
#endif
        switch (s) {
        case 0: case 7: {
            pg8::Gemm g{Xb, wt + (s == 0 ? LW_UP1 : LW_UP2), MPAD, 2 * DFF, D}; S.init(MPAD, 2 * DFF, gridDim.x, blockIdx.x);
            pg8::EpiSwiglu E{Hb, DFF}; pg8::gemm_phase(lds, g, S, E, tid); } break;
        case 1: case 8: {
            const int gi = s == 1 ? 6 : 30; const unsigned gen = (unsigned)(l * 3 + (s == 1 ? 1 : 3));
            float* outp = (s == 8 && l == DEPTH - 1) ? p.out : nullptr;
            sample_gemm_resid(Hb, DFF, wt + (s == 1 ? LW_DN1 : LW_DN2), Ypre, Xf, ALPHA, 0.5f, smem, tid);
            sample_arrive(p, tid);
            pg8::Gemm g{Hb, wt + (s == 1 ? LW_DN1 : LW_DN2), MP, D, DFF}; S.init(MP, D, gridDim.x, blockIdx.x);
            pg8::EpiResidLN E{Xf, Xb, outp, p.in[gi] + (size_t)l * D, p.in[gi + 1] + (size_t)l * D, ALPHA, 0.5f, (float*)(p.ws + WS_XCH), (unsigned*)(p.ws + WS_BAR) + 64, gen};
            pg8::gemm_phase(lds, g, S, E, tid);
            sample_ln(p, gen, Ypre, p.in[gi] + (size_t)l * D, p.in[gi + 1] + (size_t)l * D, Xf, Xb, outp, tid); } break;
        case 2: {
            pg8::Gemm g{Xb, wt + LW_WIN, MPAD, PN, D}; S.init(MPAD, PN, gridDim.x, blockIdx.x);
            pg8::EpiProj E{Pb, PN, (const float*)(p.ws + WS_BIASP) + (size_t)l * PN}; pg8::gemm_phase(lds, g, S, E, tid); } break;
        case 3: phase_m1(p, l, smem, tid, dbl); break;
        case 4: phase_m2(p, l, smem, tid); break;
        case 5: phase_m3(p, l, smem, tid); break;
        case 6: {
            const unsigned gen = (unsigned)(l * 3 + 2);
            sample_gemm_resid(Mg, D, wt + LW_WO, Ypre, Xf, ALPHA, 1.0f, smem, tid);
            sample_arrive(p, tid);
            pg8::Gemm g{Mg, wt + LW_WO, MP, D, D}; S.init(MP, D, gridDim.x, blockIdx.x);
            pg8::EpiResidLN E{Xf, Xb, nullptr, p.in[25] + (size_t)l * D, p.in[26] + (size_t)l * D, ALPHA, 1.0f, (float*)(p.ws + WS_XCH), (unsigned*)(p.ws + WS_BAR) + 64, gen};
            pg8::gemm_phase(lds, g, S, E, tid);
            sample_ln(p, gen, Ypre, p.in[25] + (size_t)l * D, p.in[26] + (size_t)l * D, Xf, Xb, nullptr, tid); } break;
        }
        }
    }
}

extern "C" void kernel_launch(void* const* d_in, const int* in_sizes, int n_in, void* d_out, int out_size, void* d_ws, size_t ws_size, hipStream_t stream) {
    static int grid = 0;
    if (grid == 0) {
        if (n_in != 32 || (size_t)out_size != O_END || ws_size < WS_END) { fprintf(stderr, "kernel_launch: unexpected shapes: n_in %d out %d ws %zu (need %zu)\n", n_in, out_size, ws_size, (size_t)WS_END); grid = -1; return; }
        int dev = 0, cus = 0, per_cu = 0;
        hipGetDevice(&dev); hipDeviceGetAttribute(&cus, hipDeviceAttributeMultiprocessorCount, dev);
        if (hipFuncSetAttribute((const void*)mega, hipFuncAttributeMaxDynamicSharedMemorySize, LDS_BYTES) != hipSuccess) { fprintf(stderr, "hipFuncSetAttribute failed\n"); grid = -1; return; }
        if (hipOccupancyMaxActiveBlocksPerMultiprocessor(&per_cu, (const void*)mega, 512, LDS_BYTES) != hipSuccess || per_cu < 1) { fprintf(stderr, "occupancy query: %d\n", per_cu); per_cu = 1; }
        (void)hipGetLastError();
        grid = cus * (per_cu > 1 ? 1 : per_cu);
    }
    if (grid < 0) return;
    Params p{};
    for (int i = 0; i < 32; ++i) p.in[i] = (const float*)d_in[i];
    p.out = (float*)d_out; p.ws = (unsigned char*)d_ws;
#if COOP
    hipMemsetAsync((char*)d_ws + WS_BAR, 0, 1024, stream);
    int lo = 0, hi = NPH, dbl = DBL;
    void* args[] = {&p, &lo, &hi, &dbl};
    hipError_t e = hipLaunchCooperativeKernel((const void*)mega, dim3(grid), dim3(512), args, LDS_BYTES, stream);
    if (e != hipSuccess) fprintf(stderr, "cooperative launch failed: %s (grid %d)\n", hipGetErrorString(e), grid);
#else
    for (int ph = 0; ph < NPH; ++ph) hipLaunchKernelGGL(mega, dim3(grid), dim3(512), LDS_BYTES, stream, p, ph, ph + 1, 0);
#endif
}
```

```cpp
#include <hip/hip_runtime.h>
#include <hip/hip_cooperative_groups.h>
#include <cstdio>
namespace cg = cooperative_groups;

#ifndef COOP
#define COOP 1
#endif
#ifndef PHM
#define PHM 0xFFFFF
#endif
#define PON(k) ((PHM >> (k)) & 1)
#ifndef DBL
#define DBL 0
#endif
#ifndef XSYNC
#define XSYNC 0
#endif

#define LAS __attribute__((address_space(3)))
typedef unsigned short bf16_t;
typedef short bf16x8 __attribute__((ext_vector_type(8)));
typedef float f32x4 __attribute__((ext_vector_type(4)));
typedef unsigned u32x4 __attribute__((ext_vector_type(4)));
typedef unsigned u32x2 __attribute__((ext_vector_type(2)));

constexpr int D = 1024, SEQ = 2048, NB = 8, DEPTH = 4, DEC = 128, DFF = 2816;
constexpr int MP = NB * SEQ;
constexpr int MV = MP + DEC;
constexpr int MPAD = 16640;
constexpr int NH = 8, CCH = 3072, DIN = 8208, PN = 8448;
constexpr int NCHK = 32;
constexpr float ALPHA = 1.681792830507429f;
constexpr int LDS_BYTES = 144 * 1024;

constexpr int PC_RGX = 0, PC_RGY = 1024, PC_Q = 2048, PC_Z = 5120, PC_GA = 6144, PC_GB = 7168, PC_A = 8192, PC_B = 8200;

constexpr size_t O_YP = 0, O_YS = O_YP + (size_t)MP * D, O_PH = O_YS + (size_t)DEC * D, O_PRC = O_PH + (size_t)DEPTH * NB * D,
                 O_PS = O_PRC + (size_t)DEPTH * NB * 3 * D, O_PGC = O_PS + (size_t)DEPTH * NB * NH * 128 * 128,
                 O_SH = O_PGC + (size_t)DEPTH * NB * 3 * CCH, O_SRC = O_SH + (size_t)DEPTH * DEC * D,
                 O_SS = O_SRC + (size_t)DEPTH * DEC * 3 * D, O_SGC = O_SS + (size_t)DEPTH * DEC * NH * 128 * 128,
                 O_END = O_SGC + (size_t)DEPTH * DEC * 3 * CCH;

constexpr size_t LW_UP1 = 0, LW_DN1 = 5767168, LW_WIN = 8650752, LW_WO = 17301504, LW_UP2 = 18350080, LW_DN2 = 24117248, LW_END = 27000832;
constexpr size_t al256(size_t x) { return (x + 255) & ~(size_t)255; }
constexpr size_t WS_WT = 0;
constexpr size_t WS_BIASP = al256(WS_WT + (size_t)DEPTH * LW_END * 2);
constexpr size_t WS_RGW = al256(WS_BIASP + (size_t)DEPTH * PN * 4);
constexpr size_t WS_XF = al256(WS_RGW + (size_t)DEPTH * 16 * 2 * 4 * 2 * 64 * 8 * 2);
constexpr size_t WS_XB = al256(WS_XF + (size_t)MPAD * D * 4);
constexpr size_t WS_P = al256(WS_XB + (size_t)MPAD * D * 2);
constexpr size_t WS_MG = al256(WS_P + (size_t)MPAD * PN * 2);
constexpr size_t WS_OA = al256(WS_MG + (size_t)MPAD * D * 2);
constexpr size_t WS_PA = al256(WS_OA + (size_t)MP * D * 2);
constexpr size_t WS_O = al256(WS_PA + (size_t)MP * D * 2);
constexpr size_t WS_TOT = al256(WS_O + (size_t)MP * D * 4);
constexpr size_t WS_PREP = al256(WS_TOT + (size_t)2 * NB * NCHK * D * 4);
constexpr int NCI = NB * NH * NCHK;
constexpr size_t PR_QD = 0, PR_KT = PR_QD + (size_t)NCI * 8192 * 2, PR_WQ = PR_KT + (size_t)NCI * 8192 * 2, PR_UU = PR_WQ + (size_t)NCI * 8192 * 2,
                 PR_AI = PR_UU + (size_t)NCI * 8192 * 4, PR_GL = PR_AI + (size_t)NCI * 4096 * 2, PR_END = PR_GL + (size_t)NCI * 4;
constexpr size_t WS_BAR = al256(WS_PREP + PR_END);
constexpr size_t WS_XCH = WS_BAR + 1024;
constexpr size_t WS_END = WS_XCH + (size_t)64 * 256 * 4 * 8;
static_assert(PR_END >= (size_t)MPAD * D * 4, "Ypre alias");

struct Params { const float* in[32]; float* out; unsigned char* ws; };

__device__ __forceinline__ void grid_barrier(unsigned* bar, unsigned target) {
    asm volatile("s_waitcnt vmcnt(0) lgkmcnt(0)" ::: "memory");
    __syncthreads();
    if (threadIdx.x == 0) {
        __builtin_amdgcn_fence(__ATOMIC_RELEASE, "agent");
        asm volatile("s_waitcnt vmcnt(0)" ::: "memory");
        __hip_atomic_fetch_add(bar, 1u, __ATOMIC_RELAXED, __HIP_MEMORY_SCOPE_AGENT);
        while (__hip_atomic_load(bar, __ATOMIC_RELAXED, __HIP_MEMORY_SCOPE_AGENT) < target) __builtin_amdgcn_s_sleep(40);
        __builtin_amdgcn_fence(__ATOMIC_ACQUIRE, "agent");
        asm volatile("s_waitcnt vmcnt(0)" ::: "memory");
    }
    __syncthreads();
}

__device__ __forceinline__ float bf2f(unsigned short b) { return __uint_as_float(((unsigned)b) << 16); }
__device__ __forceinline__ unsigned pk2(float lo, float hi) { unsigned r; asm("v_cvt_pk_bf16_f32 %0, %1, %2" : "=v"(r) : "v"(lo), "v"(hi)); return r; }
__device__ __forceinline__ unsigned short f2bf(float f) { return (unsigned short)(pk2(f, f) & 0xffffu); }
__device__ __forceinline__ float blo(unsigned w) { return __uint_as_float(w << 16); }
__device__ __forceinline__ float bhi(unsigned w) { return __uint_as_float(w & 0xffff0000u); }
__device__ __forceinline__ float sigmoidf_(float x) { return __builtin_amdgcn_rcpf(1.0f + __expf(-x)); }
__device__ __forceinline__ float siluf_(float x) { return x * __builtin_amdgcn_rcpf(1.0f + __expf(-x)); }
__device__ __forceinline__ float softplusf_(float x) { const float e = __expf(-fabsf(x)); const float l = (e < 0.01f) ? e * (1.0f - e * (0.5f - e * 0.33333334f)) : __logf(1.0f + e); return fmaxf(x, 0.f) + l; }
__device__ __forceinline__ float one_minus_exp(float t) { return (t > -0.02f) ? -t * (1.0f + t * (0.5f + t * 0.16666667f)) : 1.0f - __expf(t); }
__device__ __forceinline__ float geluf_(float x) { const float y = 0.7978845608028654f * (x + 0.044715f * x * x * x); const float t = 1.0f - 2.0f * __builtin_amdgcn_rcpf(__expf(2.0f * y) + 1.0f); return 0.5f * x * (1.0f + t); }
__device__ __forceinline__ void unpack8(const u32x4 r, float* o) { o[0] = blo(r.x); o[1] = bhi(r.x); o[2] = blo(r.y); o[3] = bhi(r.y); o[4] = blo(r.z); o[5] = bhi(r.z); o[6] = blo(r.w); o[7] = bhi(r.w); }
__device__ __forceinline__ u32x4 pack8(const float* v) { u32x4 w; w.x = pk2(v[0], v[1]); w.y = pk2(v[2], v[3]); w.z = pk2(v[4], v[5]); w.w = pk2(v[6], v[7]); return w; }
__device__ __forceinline__ float wave_sum(float s) { s += __shfl_xor(s, 32); s += __shfl_xor(s, 16); s += __shfl_xor(s, 8); s += __shfl_xor(s, 4); s += __shfl_xor(s, 2); s += __shfl_xor(s, 1); return s; }

namespace pg8 {
constexpr int BM = 256, BK = 64, HALF = 128, HTB = HALF * BK * 2, STAGE_BYTES = 8 * HTB, NXCD = 8, WGM = 8;
__device__ __forceinline__ int lds_byte(int r, int c) { const int st = (r >> 4) * 2 + (c >> 5), rr = r & 15, cc = c & 31, ob = rr * 64 + cc * 2; return st * 1024 + (ob ^ (((ob >> 9) & 1) << 5)); }
__device__ __forceinline__ void stage_rc(int b, int& R, int& C) { const int st = b / 1024, sb = b % 1024, swz = sb ^ (((sb >> 9) & 1) << 5); R = (st >> 1) * 16 + swz / 64; C = (st & 1) * 32 + (swz % 64) / 2; }
__device__ __forceinline__ int perm32(int rho) { const int n = rho >> 4, i = rho & 15; return 8 * (i >> 2) + 4 * n + (i & 3); }
struct Unit { int pm, pn; };
struct Gemm { const bf16_t* A; const bf16_t* Bt; int M, N, K; };
struct StaticOrder {
    int nM, nN, nwg, G, c;
    __device__ void init(int M, int N, int G_, int c_) { nM = M / BM; nN = N / BM; nwg = nM * nN; G = G_; c = c_; }
    __device__ bool next(int i, Unit& u) const {
        const long L = (long)i * G + c; if (L >= nwg) return false;
        int wgid = (int)L; { const int q = nwg / NXCD, r = nwg % NXCD, xcd = wgid % NXCD, off = wgid / NXCD; wgid = (xcd < r ? xcd * (q + 1) : r * (q + 1) + (xcd - r) * q) + off; }
        const int nig = WGM * nN, gid = wgid / nig, fm = gid * WGM, gsz = (nM - fm) < WGM ? (nM - fm) : WGM;
        u.pm = fm + ((wgid % nig) % gsz); u.pn = (wgid % nig) / gsz; return true;
    }
};
__device__ __forceinline__ unsigned cvt_pk_bf16(float lo, float hi) { unsigned r; asm volatile("v_cvt_pk_bf16_f32 %0, %1, %2" : "=v"(r) : "v"(lo), "v"(hi)); return r; }

struct EpiSwiglu {
    static constexpr bool PERM = true, AFTER_DRAIN = false;
    bf16_t* H; int ldh;
    __device__ __forceinline__ void operator()(const f32x4 (&acc)[2][2][4][2], const Unit& u, int wr, int wc, int fr, int fq) const {
        const int row0 = u.pm * BM + wr * 64 + fr, col0 = u.pn * HALF + wc * 32 + 8 * fq;
#pragma unroll
        for (int ai = 0; ai < 2; ++ai)
#pragma unroll
            for (int m = 0; m < 4; ++m) {
                bf16_t* rowp = H + (size_t)(row0 + ai * HALF + m * 16) * ldh + col0;
                float o[8];
#pragma unroll
                for (int n = 0; n < 2; ++n)
#pragma unroll
                    for (int j = 0; j < 4; ++j) { const float a = acc[ai][0][m][n][j], b = acc[ai][1][m][n][j]; o[n * 4 + j] = siluf_(a) * b; }
                u32x4 w; w.x = cvt_pk_bf16(o[0], o[1]); w.y = cvt_pk_bf16(o[2], o[3]); w.z = cvt_pk_bf16(o[4], o[5]); w.w = cvt_pk_bf16(o[6], o[7]);
                *(u32x4*)rowp = w;
            }
    }
};
struct EpiProj {
    static constexpr bool PERM = true, AFTER_DRAIN = false;
    bf16_t* O; int ldc; const float* bias;
    __device__ __forceinline__ void operator()(const f32x4 (&acc)[2][2][4][2], const Unit& u, int wr, int wc, int fr, int fq) const {
        const int row0 = u.pm * BM + wr * 64 + fr, col0 = u.pn * BM + wc * 32 + 8 * fq;
        f32x4 bv[2][2];
#pragma unroll
        for (int bj = 0; bj < 2; ++bj)
#pragma unroll
            for (int n = 0; n < 2; ++n) bv[bj][n] = *(const f32x4*)(bias + col0 + bj * HALF + 4 * n);
#pragma unroll
        for (int ai = 0; ai < 2; ++ai)
#pragma unroll
            for (int m = 0; m < 4; ++m) {
                bf16_t* rowp = O + (size_t)(row0 + ai * HALF + m * 16) * ldc + col0;
#pragma unroll
                for (int bj = 0; bj < 2; ++bj) {
                    const f32x4 v0 = acc[ai][bj][m][0] + bv[bj][0], v1 = acc[ai][bj][m][1] + bv[bj][1];
                    u32x4 w; w.x = cvt_pk_bf16(v0[0], v0[1]); w.y = cvt_pk_bf16(v0[2], v0[3]); w.z = cvt_pk_bf16(v1[0], v1[1]); w.w = cvt_pk_bf16(v1[2], v1[3]);
                    *(u32x4*)(rowp + bj * HALF) = w;
                }
            }
    }
};
struct EpiResid {
    static constexpr bool PERM = false, AFTER_DRAIN = false;
    float* Y; const float* R; int ldc; float alpha, s;
    __device__ __forceinline__ void operator()(const f32x4 (&acc)[2][2][4][2], const Unit& u, int wr, int wc, int fr, int fq) const {
        const int row0 = u.pm * BM + wr * 64 + fr, col0 = u.pn * BM + wc * 32 + 4 * fq;
#pragma unroll
        for (int ai = 0; ai < 2; ++ai)
#pragma unroll
            for (int m = 0; m < 4; ++m) {
                const size_t ro = (size_t)(row0 + ai * HALF + m * 16) * ldc + col0;
#pragma unroll
                for (int bj = 0; bj < 2; ++bj)
#pragma unroll
                    for (int n = 0; n < 2; ++n) { const f32x4 r = *(const f32x4*)(R + ro + bj * HALF + n * 16); *(f32x4*)(Y + ro + bj * HALF + n * 16) = r * alpha + acc[ai][bj][m][n] * s; }
            }
    }
};

struct EpiResidLN {
    static constexpr bool PERM = false, AFTER_DRAIN = true;
    float* Xf; bf16_t* Xb; float* out; const float* g; const float* b; float alpha, s; float* xbuf; unsigned* cnt; unsigned gen;
    __device__ __forceinline__ void fused(f32x4 (&acc)[2][2][4][2], const Unit& u, int wr, int wc, int fr, int fq, LAS unsigned char* lds, const int tid) const {
        typedef float f32x2 __attribute__((ext_vector_type(2)));
        LAS f32x2* tab = (LAS f32x2*)lds;
        LAS f32x2* stat = (LAS f32x2*)(lds + 8192);
        const int row0 = u.pm * BM + wr * 64 + fr, col0 = u.pn * BM + wc * 32 + 4 * fq;
#pragma unroll
        for (int ai = 0; ai < 2; ++ai)
#pragma unroll
            for (int m = 0; m < 4; ++m) {
                const size_t ro = (size_t)(row0 + ai * HALF + m * 16) * 1024 + col0;
                float s1 = 0.f, s2 = 0.f;
#pragma unroll
                for (int bj = 0; bj < 2; ++bj)
#pragma unroll
                    for (int n = 0; n < 2; ++n) { const f32x4 r = *(const f32x4*)(Xf + ro + bj * HALF + n * 16); const f32x4 y = r * alpha + acc[ai][bj][m][n] * s; acc[ai][bj][m][n] = y;
                        s1 += (y[0] + y[1]) + (y[2] + y[3]); s2 += (y[0] * y[0] + y[1] * y[1]) + (y[2] * y[2] + y[3] * y[3]); }
                s1 += __shfl_xor(s1, 16); s1 += __shfl_xor(s1, 32); s2 += __shfl_xor(s2, 16); s2 += __shfl_xor(s2, 32);
                if (fq == 0) tab[(ai * HALF + wr * 64 + m * 16 + fr) * 4 + wc] = (f32x2){s1, s2};
            }
        __syncthreads();
        if (tid < 256) { const f32x2 a = tab[tid * 4], b2 = tab[tid * 4 + 1], c = tab[tid * 4 + 2], d = tab[tid * 4 + 3];
            unsigned* xs = (unsigned*)(xbuf + (((size_t)u.pm * 4 + u.pn) * 256 + tid) * 2);
            __hip_atomic_store(xs, __float_as_uint((a.x + b2.x) + (c.x + d.x)), __ATOMIC_RELAXED, __HIP_MEMORY_SCOPE_AGENT);
            __hip_atomic_store(xs + 1, __float_as_uint((a.y + b2.y) + (c.y + d.y)), __ATOMIC_RELAXED, __HIP_MEMORY_SCOPE_AGENT); }
        asm volatile("s_waitcnt vmcnt(0)" ::: "memory");
        __syncthreads();
        if (tid == 0) {
            __hip_atomic_fetch_add(cnt + u.pm, 1u, __ATOMIC_RELAXED, __HIP_MEMORY_SCOPE_AGENT);
            while (__hip_atomic_load(cnt + u.pm, __ATOMIC_RELAXED, __HIP_MEMORY_SCOPE_AGENT) < 4u * gen) __builtin_amdgcn_s_sleep(10);
        }
        __syncthreads();
        if (tid < 256) { unsigned* xp = (unsigned*)(xbuf + ((size_t)u.pm * 4 * 256 + tid) * 2);
            f32x2 q0, q1, q2, q3;
            q0.x = __uint_as_float(__hip_atomic_load(xp, __ATOMIC_RELAXED, __HIP_MEMORY_SCOPE_AGENT)); q0.y = __uint_as_float(__hip_atomic_load(xp + 1, __ATOMIC_RELAXED, __HIP_MEMORY_SCOPE_AGENT));
            q1.x = __uint_as_float(__hip_atomic_load(xp + 512, __ATOMIC_RELAXED, __HIP_MEMORY_SCOPE_AGENT)); q1.y = __uint_as_float(__hip_atomic_load(xp + 513, __ATOMIC_RELAXED, __HIP_MEMORY_SCOPE_AGENT));
            q2.x = __uint_as_float(__hip_atomic_load(xp + 1024, __ATOMIC_RELAXED, __HIP_MEMORY_SCOPE_AGENT)); q2.y = __uint_as_float(__hip_atomic_load(xp + 1025, __ATOMIC_RELAXED, __HIP_MEMORY_SCOPE_AGENT));
            q3.x = __uint_as_float(__hip_atomic_load(xp + 1536, __ATOMIC_RELAXED, __HIP_MEMORY_SCOPE_AGENT)); q3.y = __uint_as_float(__hip_atomic_load(xp + 1537, __ATOMIC_RELAXED, __HIP_MEMORY_SCOPE_AGENT));
            const float mean = ((q0.x + q1.x) + (q2.x + q3.x)) * (1.0f / 1024.0f), ex2 = ((q0.y + q1.y) + (q2.y + q3.y)) * (1.0f / 1024.0f);
            stat[tid] = (f32x2){mean, rsqrtf(fmaxf(ex2 - mean * mean, 0.f) + 1e-5f)}; }
        __syncthreads();
#pragma unroll
        for (int ai = 0; ai < 2; ++ai)
#pragma unroll
            for (int m = 0; m < 4; ++m) {
                const f32x2 st = stat[ai * HALF + wr * 64 + m * 16 + fr];
                const size_t ro = (size_t)(row0 + ai * HALF + m * 16) * 1024 + col0;
#pragma unroll
                for (int bj = 0; bj < 2; ++bj)
#pragma unroll
                    for (int n = 0; n < 2; ++n) { const int c = col0 + bj * HALF + n * 16; const f32x4 gv = *(const f32x4*)(g + c), bv = *(const f32x4*)(b + c);
                        const f32x4 y = (acc[ai][bj][m][n] - st.x) * st.y * gv + bv; const size_t o = ro + bj * HALF + n * 16;
                        *(f32x4*)(Xf + o) = y; u32x2 w; w.x = cvt_pk_bf16(y[0], y[1]); w.y = cvt_pk_bf16(y[2], y[3]); *(u32x2*)(Xb + o) = w;
                        if (out) *(f32x4*)(out + o) = y; }
            }
    }
};

template <class Epi>
__device__ __forceinline__ void gemm_phase(LAS unsigned char* lds, const Gemm g, const StaticOrder& S, const Epi& E, const int tid) {
    const int wid = __builtin_amdgcn_readfirstlane(tid >> 6), lane = tid & 63, wr = wid >> 2, wc = wid & 3, fr = lane & 15, fq = lane >> 4;
    const int K = g.K, nt = K / BK;
    unsigned voffA[2], voffB[2];
#pragma unroll
    for (int i = 0; i < 2; ++i) { int R, C; stage_rc(tid * 16 + i * 8192, R, C); const int Rb = Epi::PERM ? ((R & ~31) + perm32(R & 31)) : R;
        voffA[i] = (unsigned)(R * K + C) * 2u; voffB[i] = (unsigned)(Rb * K + C) * 2u; }
    const size_t kstep = (size_t)(BK * 2);
    const size_t hstep = (size_t)HALF * K * 2;
    const size_t tstep = 2 * hstep;
    const unsigned ldsw = (unsigned)wid * 1024u;
    const int aoff = lds_byte(wr * 64 + fr, fq * 8), boff = lds_byte(wc * 32 + fr, fq * 8);
#define PG8_SA(b, h) (((b) * 2 + (h)) * HTB)
#define PG8_SB(b, h) ((4 + (b) * 2 + (h)) * HTB)
#define PG8_STAGE(bufoff, gbase, voff) do { _Pragma("unroll") for (int _i = 0; _i < 2; ++_i) \
        __builtin_amdgcn_global_load_lds((const unsigned*)((const char*)(gbase) + (voff)[_i]), (LAS unsigned*)(lds + (bufoff) + ldsw + _i * 8192), 16, 0, 0); } while (0)
#define PG8_LDA(dst, b, h) do { _Pragma("unroll") for (int m = 0; m < 4; ++m) _Pragma("unroll") for (int k = 0; k < 2; ++k) dst[m][k] = *(const LAS bf16x8*)(lds + PG8_SA(b, h) + aoff + m * 2048 + k * 1024); } while (0)
#define PG8_LDB(dst, b, h) do { _Pragma("unroll") for (int n = 0; n < 2; ++n) _Pragma("unroll") for (int k = 0; k < 2; ++k) dst[n][k] = *(const LAS bf16x8*)(lds + PG8_SB(b, h) + boff + n * 2048 + k * 1024); } while (0)
#define PG8_MMA(ai, bj, At, Bt) do { __builtin_amdgcn_s_setprio(1); _Pragma("unroll") for (int m = 0; m < 4; ++m) _Pragma("unroll") for (int n = 0; n < 2; ++n) _Pragma("unroll") for (int k = 0; k < 2; ++k) \
        acc[ai][bj][m][n] = __builtin_amdgcn_mfma_f32_16x16x32_bf16(Bt[n][k], At[m][k], acc[ai][bj][m][n], 0, 0, 0); __builtin_amdgcn_s_setprio(0); } while (0)
#define PG8_WAIT_V(n) asm volatile("s_waitcnt vmcnt(" #n ")" ::: "memory")
#define PG8_WAIT_L(n) asm volatile("s_waitcnt lgkmcnt(" #n ")" ::: "memory")
#define PG8_BAR __builtin_amdgcn_s_barrier()
#define PG8_SCHED __builtin_amdgcn_sched_barrier(0)
    Unit cur, nxt; int ui = 0;
    if (!S.next(0, cur)) return;
    f32x4 acc[2][2][4][2];
#pragma unroll
    for (int a = 0; a < 2; ++a)
#pragma unroll
        for (int b = 0; b < 2; ++b)
#pragma unroll
            for (int m = 0; m < 4; ++m)
#pragma unroll
                for (int n = 0; n < 2; ++n) acc[a][b][m][n] = (f32x4){0.f, 0.f, 0.f, 0.f};
    bf16x8 At[4][2], B0[2][2], B1[2][2];
    const char* cA = (const char*)g.A + (size_t)cur.pm * tstep; const char* cB = (const char*)g.Bt + (size_t)cur.pn * tstep;
    PG8_STAGE(PG8_SB(0, 0), cB, voffB); PG8_STAGE(PG8_SA(0, 0), cA, voffA); PG8_STAGE(PG8_SB(0, 1), cB + hstep, voffB); PG8_STAGE(PG8_SA(0, 1), cA + hstep, voffA);
    if (wr == 1) PG8_BAR;
    PG8_WAIT_V(4); PG8_BAR;
    PG8_STAGE(PG8_SB(1, 0), cB + kstep, voffB); PG8_STAGE(PG8_SA(1, 0), cA + kstep, voffA); PG8_STAGE(PG8_SB(1, 1), cB + hstep + kstep, voffB);
    PG8_WAIT_V(6); PG8_BAR;
    for (;;) {
        const bool has_next = S.next(ui + 1, nxt);
        const char* nA = has_next ? (const char*)g.A + (size_t)nxt.pm * tstep : cA; const char* nB = has_next ? (const char*)g.Bt + (size_t)nxt.pn * tstep : cB;
        for (int t = 0; t < nt; t += 2) {
            const bool last = (t == nt - 2);
            const char* a1 = cA + (size_t)(t + 1) * kstep;
            const char* a2 = last ? nA : cA + (size_t)(t + 2) * kstep; const char* b2 = last ? nB : cB + (size_t)(t + 2) * kstep;
            const char* a3 = a2 + kstep; const char* b3 = b2 + kstep;
            PG8_LDB(B0, 0, 0); PG8_SCHED; PG8_LDA(At, 0, 0); PG8_STAGE(PG8_SA(1, 1), a1 + hstep, voffA);
            PG8_WAIT_L(8); PG8_BAR; PG8_WAIT_L(0); PG8_MMA(0, 0, At, B0); PG8_BAR; PG8_SCHED;
            PG8_LDB(B1, 0, 1); PG8_STAGE(PG8_SB(0, 0), b2, voffB);
            PG8_BAR; PG8_WAIT_L(0); PG8_MMA(0, 1, At, B1); PG8_BAR;
            PG8_LDA(At, 0, 1); PG8_STAGE(PG8_SA(0, 0), a2, voffA);
            PG8_BAR; PG8_WAIT_L(0); PG8_MMA(1, 0, At, B0); PG8_BAR; PG8_SCHED;
            PG8_STAGE(PG8_SB(0, 1), b2 + hstep, voffB);
            PG8_WAIT_V(6); PG8_BAR; PG8_MMA(1, 1, At, B1); PG8_BAR;
            PG8_LDB(B0, 1, 0); PG8_SCHED; PG8_LDA(At, 1, 0); PG8_STAGE(PG8_SA(0, 1), a2 + hstep, voffA);
            PG8_WAIT_L(8); PG8_BAR; PG8_WAIT_L(0); PG8_MMA(0, 0, At, B0); PG8_BAR; PG8_SCHED;
            PG8_LDB(B1, 1, 1); PG8_STAGE(PG8_SB(1, 0), b3, voffB);
            PG8_BAR; PG8_WAIT_L(0); PG8_MMA(0, 1, At, B1); PG8_BAR;
            PG8_LDA(At, 1, 1); PG8_STAGE(PG8_SA(1, 0), a3, voffA);
            PG8_BAR; PG8_WAIT_L(0); PG8_MMA(1, 0, At, B0); PG8_BAR; PG8_SCHED;
            PG8_STAGE(PG8_SB(1, 1), b3 + hstep, voffB);
            PG8_WAIT_V(6); PG8_BAR; PG8_MMA(1, 1, At, B1); PG8_BAR;
        }
        if constexpr (!Epi::AFTER_DRAIN) E(acc, cur, wr, wc, fr, fq);
        if (!has_next) break;
#pragma unroll
        for (int a = 0; a < 2; ++a)
#pragma unroll
            for (int b = 0; b < 2; ++b)
#pragma unroll
                for (int m = 0; m < 4; ++m)
#pragma unroll
                    for (int n = 0; n < 2; ++n) acc[a][b][m][n] = (f32x4){0.f, 0.f, 0.f, 0.f};
        cur = nxt; cA = nA; cB = nB; ++ui;
    }
    PG8_WAIT_V(0);
    if (wr == 0) PG8_BAR;
    PG8_BAR;
    if constexpr (Epi::AFTER_DRAIN) E.fused(acc, cur, wr, wc, fr, fq, lds, tid);
#undef PG8_SA
#undef PG8_SB
#undef PG8_STAGE
#undef PG8_LDA
#undef PG8_LDB
#undef PG8_MMA
#undef PG8_WAIT_V
#undef PG8_WAIT_L
#undef PG8_BAR
#undef PG8_SCHED
}
}

__device__ void sample_gemm_resid(const bf16_t* A, int K, const bf16_t* Bt, float* Y, const float* R, float alpha, float sc, unsigned char* smem, int tid) {
    const int wid = __builtin_amdgcn_readfirstlane(tid >> 6), lane = tid & 63, fr = lane & 15, fq = lane >> 4, mbk = wid & 1, kq = wid >> 1;
    f32x4* part = (f32x4*)smem;
    const int Kq = K >> 2;
    for (int t = blockIdx.x; t < 256; t += gridDim.x) {
        const int cbk = 2 * (t & 31) + mbk, row0 = MP + 16 * (t >> 5);
        const bf16_t* ap = A + (size_t)(row0 + fr) * K + kq * Kq + 8 * fq;
        const bf16_t* bp = Bt + (size_t)(16 * cbk + fr) * K + kq * Kq + 8 * fq;
        f32x4 acc0 = (f32x4){0.f, 0.f, 0.f, 0.f}, acc1 = (f32x4){0.f, 0.f, 0.f, 0.f};
#pragma unroll 4
        for (int k = 0; k < Kq; k += 64) {
            const bf16x8 a0 = *(const bf16x8*)(ap + k), b0 = *(const bf16x8*)(bp + k), a1 = *(const bf16x8*)(ap + k + 32), b1 = *(const bf16x8*)(bp + k + 32);
            acc0 = __builtin_amdgcn_mfma_f32_16x16x32_bf16(a0, b0, acc0, 0, 0, 0); acc1 = __builtin_amdgcn_mfma_f32_16x16x32_bf16(a1, b1, acc1, 0, 0, 0);
        }
        __syncthreads();
        part[(kq * 2 + mbk) * 64 + lane] = acc0 + acc1;
        __syncthreads();
        if (kq == 0) {
            const f32x4 sm = (part[mbk * 64 + lane] + part[(2 + mbk) * 64 + lane]) + (part[(4 + mbk) * 64 + lane] + part[(6 + mbk) * 64 + lane]);
#pragma unroll
            for (int j = 0; j < 4; ++j) { const size_t o = (size_t)(row0 + 4 * fq + j) * D + 16 * cbk + fr; Y[o] = alpha * R[o] + sc * sm[j]; }
        }
    }
}

__device__ __forceinline__ void transpose_tile(const float* src, int ld, int col0, int ncv, bf16_t* dst, int K, int r0, int k0, float* tile, int tid) {
#pragma unroll
    for (int e = 0; e < 8; ++e) { const int kk = e * 8 + (tid >> 6), n = tid & 63; tile[kk * 65 + n] = (n < ncv) ? src[(size_t)(k0 + kk) * ld + col0 + n] : 0.f; }
    __syncthreads();
    { const int n = tid >> 3, kq = tid & 7; float v[8];
#pragma unroll
      for (int i = 0; i < 8; ++i) v[i] = tile[(kq * 8 + i) * 65 + n];
      *(u32x4*)(dst + (size_t)(r0 + n) * K + k0 + kq * 8) = pack8(v); }
    __syncthreads();
}
__device__ __forceinline__ int win_col(int r) { return r < 6144 ? r : (r < 8192 ? r + 16 : (r < 8208 ? r - 8192 + 6144 : -1)); }

struct TileJob { const float* src; bf16_t* dst; int ld, col0, ncv, K, r0, k0; };
__device__ __forceinline__ TileJob tile_decode(const Params& p, int t) {
    constexpr int TPL = 6592;
    TileJob j; const int l = t / TPL; int r = t % TPL;
    bf16_t* wt = (bf16_t*)(p.ws + WS_WT) + (size_t)l * LW_END;
    j.ncv = 64;
    if (r < 1408 || (r >= 4480 && r < 5888)) {
        const bool second = r >= 4480; if (second) r -= 4480;
        const int rt = r / 16, kt = r % 16, r0 = rt * 64, pn = r0 / 256, rr = r0 % 256;
        j.src = p.in[second ? (rr < 128 ? 27 : 28) : (rr < 128 ? 8 : 9)] + (size_t)l * D * DFF;
        j.ld = DFF; j.col0 = 128 * pn + (rr & 127); j.dst = wt + (second ? LW_UP2 : LW_UP1); j.K = D; j.r0 = r0; j.k0 = kt * 64;
    } else if ((r >= 1408 && r < 2112) || r >= 5888) {
        const bool second = r >= 5888; r -= second ? 5888 : 1408;
        const int rt = r / 44, kt = r % 44;
        j.src = p.in[second ? 29 : 10] + (size_t)l * DFF * D;
        j.ld = D; j.col0 = rt * 64; j.dst = wt + (second ? LW_DN2 : LW_DN1); j.K = DFF; j.r0 = rt * 64; j.k0 = kt * 64;
    } else if (r < 4224) {
        r -= 2112; const int rt = r / 16, kt = r % 16, r0 = rt * 64;
        if (r0 < 8192) { j.col0 = win_col(r0); } else if (r0 == 8192) { j.col0 = 6144; j.ncv = 16; } else { j.col0 = 0; j.ncv = 0; }
        j.src = p.in[11] + (size_t)l * D * DIN; j.ld = DIN; j.dst = wt + LW_WIN; j.K = D; j.r0 = r0; j.k0 = kt * 64;
    } else {
        r -= 4224; const int rt = r / 16, kt = r % 16;
        j.src = p.in[24] + (size_t)l * D * D; j.ld = D; j.col0 = rt * 64; j.dst = wt + LW_WO; j.K = D; j.r0 = rt * 64; j.k0 = kt * 64;
    }
    return j;
}
__device__ __forceinline__ void tile_load(const TileJob& j, float* v, int tid) {
#pragma unroll
    for (int e = 0; e < 8; ++e) { const int kk = e * 8 + (tid >> 6), n = tid & 63; v[e] = (n < j.ncv) ? j.src[(size_t)(j.k0 + kk) * j.ld + j.col0 + n] : 0.f; }
}
__device__ void phase_prep(const Params& p, unsigned char* smem, const int tid) {
    float* tile = (float*)smem;
    constexpr int NT = 6592 * DEPTH;
    float cur[8], nxt[8];
    int t = blockIdx.x;
    if (t < NT) { const TileJob j = tile_decode(p, t); tile_load(j, cur, tid); }
    for (; t < NT; t += gridDim.x) {
        const int tn = t + gridDim.x;
        if (tn < NT) { const TileJob jn = tile_decode(p, tn); tile_load(jn, nxt, tid); }
        const TileJob j = tile_decode(p, t);
#pragma unroll
        for (int e = 0; e < 8; ++e) tile[(e * 8 + (tid >> 6)) * 65 + (tid & 63)] = cur[e];
        __syncthreads();
        { const int n = tid >> 3, kq = tid & 7; float v[8];
#pragma unroll
          for (int i = 0; i < 8; ++i) v[i] = tile[(kq * 8 + i) * 65 + n];
          *(u32x4*)(j.dst + (size_t)(j.r0 + n) * j.K + j.k0 + kq * 8) = pack8(v); }
        __syncthreads();
#pragma unroll
        for (int e = 0; e < 8; ++e) cur[e] = nxt[e];
    }
    const size_t gt = (size_t)blockIdx.x * 512 + tid, gs = (size_t)gridDim.x * 512;
    float* biasP = (float*)(p.ws + WS_BIASP);
    for (size_t i = gt; i < (size_t)DEPTH * PN; i += gs) { const int l = (int)(i / PN), c = (int)(i % PN), sc = win_col(c); biasP[i] = sc >= 0 ? p.in[12][(size_t)l * DIN + sc] : 0.f; }
    for (size_t i = gt; i < (size_t)DEPTH * 16 * 2 * 4 * 2 * 64; i += gs) {
        const int ln = (int)(i & 63), ks = (int)(i >> 6) & 1, nb = (int)(i >> 7) & 3, gate = (int)(i >> 9) & 1, cb = (int)(i >> 10) & 15, l = (int)(i >> 14);
        const float* w = p.in[gate ? 17 : 15] + ((size_t)l * 16 + cb) * 4096; float v[8];
#pragma unroll
        for (int e = 0; e < 8; ++e) v[e] = w[(32 * ks + 8 * (ln >> 4) + e) * 64 + 16 * nb + (ln & 15)];
        *(u32x4*)(p.ws + WS_RGW + i * 16) = pack8(v);
    }
    float* Xf = (float*)(p.ws + WS_XF); bf16_t* Xb = (bf16_t*)(p.ws + WS_XB); bf16_t* Mg = (bf16_t*)(p.ws + WS_MG);
    for (size_t i = gt; i < (size_t)MPAD * D / 4; i += gs) {
        const size_t e = i * 4; const int row = (int)(e / D);
        f32x4 v = (f32x4){0.f, 0.f, 0.f, 0.f};
        if (row < MP) v = *(const f32x4*)(p.in[0] + e); else if (row < MV) v = *(const f32x4*)(p.in[1] + (e - (size_t)MP * D));
        *(f32x4*)(Xf + e) = v; u32x2 w; w.x = pk2(v[0], v[1]); w.y = pk2(v[2], v[3]); *(u32x2*)(Xb + e) = w;
        if (row >= MV) { u32x2 z; z.x = 0u; z.y = 0u; *(u32x2*)(Mg + e) = z; }
    }
}

__device__ void phase_ln(const float* Y, const float* g, const float* b, float* Xf, bf16_t* Xb, float* out, const int tid) {
    const int lane = tid & 63, gw = blockIdx.x * 8 + (tid >> 6), nw = gridDim.x * 8;
    f32x4 gv[4], bv[4];
#pragma unroll
    for (int i = 0; i < 4; ++i) { gv[i] = *(const f32x4*)(g + i * 256 + lane * 4); bv[i] = *(const f32x4*)(b + i * 256 + lane * 4); }
    for (int row = gw; row < MV; row += nw) {
        f32x4 v[4]; float s = 0.f;
#pragma unroll
        for (int i = 0; i < 4; ++i) { v[i] = *(const f32x4*)(Y + (size_t)row * D + i * 256 + lane * 4); s += (v[i][0] + v[i][1]) + (v[i][2] + v[i][3]); }
        const float mu = wave_sum(s) * (1.0f / D);
        float q = 0.f;
#pragma unroll
        for (int i = 0; i < 4; ++i) { v[i] = v[i] - mu; q += (v[i][0] * v[i][0] + v[i][1] * v[i][1]) + (v[i][2] * v[i][2] + v[i][3] * v[i][3]); }
        const float rstd = rsqrtf(wave_sum(q) * (1.0f / D) + 1e-5f);
#pragma unroll
        for (int i = 0; i < 4; ++i) {
            const f32x4 y = v[i] * rstd * gv[i] + bv[i];
            const size_t o = (size_t)row * D + i * 256 + lane * 4;
            *(f32x4*)(Xf + o) = y; u32x2 w; w.x = pk2(y[0], y[1]); w.y = pk2(y[2], y[3]); *(u32x2*)(Xb + o) = w;
            if (out) *(f32x4*)(out + o) = y;
        }
    }
}

__device__ void ln_rows(const float* Y, const float* g, const float* b, float* Xf, bf16_t* Xb, float* out, int r0, int nrows, const int tid) {
    const int lane = tid & 63, wid = tid >> 6;
    f32x4 gv[4], bv[4];
#pragma unroll
    for (int i = 0; i < 4; ++i) { gv[i] = *(const f32x4*)(g + i * 256 + lane * 4); bv[i] = *(const f32x4*)(b + i * 256 + lane * 4); }
    for (int row = r0 + wid; row < r0 + nrows; row += 8) {
        f32x4 v[4]; float sm = 0.f;
#pragma unroll
        for (int i = 0; i < 4; ++i) { v[i] = *(const f32x4*)(Y + (size_t)row * D + i * 256 + lane * 4); sm += (v[i][0] + v[i][1]) + (v[i][2] + v[i][3]); }
        const float mu = wave_sum(sm) * (1.0f / D);
        float q = 0.f;
#pragma unroll
        for (int i = 0; i < 4; ++i) { v[i] = v[i] - mu; q += (v[i][0] * v[i][0] + v[i][1] * v[i][1]) + (v[i][2] * v[i][2] + v[i][3] * v[i][3]); }
        const float rstd = rsqrtf(wave_sum(q) * (1.0f / D) + 1e-5f);
#pragma unroll
        for (int i = 0; i < 4; ++i) {
            const f32x4 y = v[i] * rstd * gv[i] + bv[i];
            const size_t o = (size_t)row * D + i * 256 + lane * 4;
            *(f32x4*)(Xf + o) = y; u32x2 w; w.x = pk2(y[0], y[1]); w.y = pk2(y[2], y[3]); *(u32x2*)(Xb + o) = w;
            if (out) *(f32x4*)(out + o) = y;
        }
    }
}
__device__ void sample_arrive(const Params& p, const int tid) {
    unsigned* cnt = (unsigned*)(p.ws + WS_BAR) + 64;
    int nt = 0; for (int t = blockIdx.x; t < 256; t += gridDim.x) ++nt;
    asm volatile("s_waitcnt vmcnt(0)" ::: "memory");
    __syncthreads();
    if (tid == 0 && nt) {
        __builtin_amdgcn_fence(__ATOMIC_RELEASE, "agent");
        asm volatile("s_waitcnt vmcnt(0)" ::: "memory");
        __hip_atomic_fetch_add(cnt + 64, (unsigned)nt, __ATOMIC_RELAXED, __HIP_MEMORY_SCOPE_AGENT);
    }
}
__device__ void sample_ln(const Params& p, unsigned gen, const float* Y, const float* g, const float* b, float* Xf, bf16_t* Xb, float* out, const int tid) {
    unsigned* cnt = (unsigned*)(p.ws + WS_BAR) + 64;
    if ((int)blockIdx.x >= DEC) return;
    if (tid == 0) {
        while (__hip_atomic_load(cnt + 64, __ATOMIC_RELAXED, __HIP_MEMORY_SCOPE_AGENT) < 256u * gen) __builtin_amdgcn_s_sleep(10);
        __builtin_amdgcn_fence(__ATOMIC_ACQUIRE, "agent");
        asm volatile("s_waitcnt vmcnt(0)" ::: "memory");
    }
    __syncthreads();
    for (int r = blockIdx.x; r < DEC; r += gridDim.x) ln_rows(Y, g, b, Xf, Xb, out, MP + r, 1, tid);
}

#define MFMA16(a, b, c) __builtin_amdgcn_mfma_f32_16x16x32_bf16((a), (b), (c), 0, 0, 0)

__device__ void rg_prompt(const Params& p, int l, int b, int n, int wid, int lane) {
    const int fr = lane & 15, fq = lane >> 4;
    const bf16_t* P = (const bf16_t*)(p.ws + WS_P);
    bf16_t* OA = (bf16_t*)(p.ws + WS_OA); bf16_t* PA = (bf16_t*)(p.ws + WS_PA);
    float* Atot = (float*)(p.ws + WS_TOT); float* Btot = Atot + (size_t)NB * NCHK * D;
    const float* rcw = p.in[13] + (size_t)l * 4 * D; const float* rcb = p.in[14] + (size_t)l * D;
    const float* wr = p.in[15] + (size_t)l * 16 * 64 * 64; const float* br = p.in[16] + (size_t)l * D;
    const float* wi = p.in[17] + (size_t)l * 16 * 64 * 64; const float* bi = p.in[18] + (size_t)l * D;
    const float* lam = p.in[19] + (size_t)l * D;
    const size_t R0 = (size_t)b * SEQ + 64 * n;
    const unsigned loffT = (unsigned)(fr * PN + 4 * fq), loffTO = (unsigned)(fr * D + 4 * fq), l4 = (unsigned)(4 * fq);
    const unsigned loffA = (unsigned)(fr * PN + 8 * fq), loffD = (unsigned)(4 * fq * PN + fr), loffO = (unsigned)(4 * fq * D + fr), l8 = (unsigned)(8 * fq), lfr = (unsigned)fr;
    for (int cbi = 0; cbi < 2; ++cbi) {
        const int cb = 2 * wid + cbi, ch0 = 64 * cb;
        bf16x8 A[4][2];
#pragma unroll
        for (int ks = 0; ks < 2; ++ks) {
            const int chb = ch0 + 32 * ks;
            f32x4 cw[4][2];
#pragma unroll
            for (int j = 0; j < 4; ++j) { const float* wu = rcw + j * D + chb; cw[j][0] = *(const f32x4*)(wu + l8); cw[j][1] = *(const f32x4*)(wu + 4 + l8); }
            const f32x4 b0 = *(const f32x4*)(rcb + chb + l8), b1 = *(const f32x4*)(rcb + chb + 4 + l8);
#pragma unroll
            for (int m = 0; m < 4; ++m) {
                const int pos = 64 * n + 16 * m + fr;
                float xc[8] = {b0[0], b0[1], b0[2], b0[3], b1[0], b1[1], b1[2], b1[3]};
#pragma unroll
                for (int j = 0; j < 4; ++j) {
                    const bool ok = pos - 3 + j >= 0;
                    const bf16_t* Pu = P + ((long)R0 + 16 * m - 3 + j) * PN + PC_RGX + chb;
                    u32x4 raw = *(const u32x4*)(Pu + loffA); if (!ok) raw = (u32x4){0u, 0u, 0u, 0u};
                    float xv[8]; unpack8(raw, xv);
                    xc[0] += cw[j][0][0] * xv[0]; xc[1] += cw[j][0][1] * xv[1]; xc[2] += cw[j][0][2] * xv[2]; xc[3] += cw[j][0][3] * xv[3];
                    xc[4] += cw[j][1][0] * xv[4]; xc[5] += cw[j][1][1] * xv[5]; xc[6] += cw[j][1][2] * xv[6]; xc[7] += cw[j][1][3] * xv[7];
                }
                const u32x4 pk = pack8(xc); A[m][ks] = *(const bf16x8*)&pk;
                __builtin_amdgcn_sched_barrier(0);
            }
        }
        const bf16x8* fw = (const bf16x8*)(p.ws + WS_RGW) + ((size_t)l * 16 + cb) * 2 * 4 * 2 * 64;
#pragma unroll 1
        for (int nb = 0; nb < 4; ++nb) {
            const bf16x8 Br0 = (fw + (nb * 2 + 0) * 64)[lane], Br1 = (fw + (nb * 2 + 1) * 64)[lane], Bi0 = (fw + (8 + nb * 2 + 0) * 64)[lane], Bi1 = (fw + (8 + nb * 2 + 1) * 64)[lane];
            const int du = ch0 + 16 * nb;
            const f32x4 w0 = *(const f32x4*)(rcw + du + l4), w1 = *(const f32x4*)(rcw + D + du + l4), w2 = *(const f32x4*)(rcw + 2 * D + du + l4), w3 = *(const f32x4*)(rcw + 3 * D + du + l4);
            const f32x4 cbias = *(const f32x4*)(rcb + du + l4), brd = *(const f32x4*)(br + du + l4), bid = *(const f32x4*)(bi + du + l4), lm = *(const f32x4*)(lam + du + l4);
            f32x4 sp; sp[0] = softplusf_(-lm[0]); sp[1] = softplusf_(-lm[1]); sp[2] = softplusf_(-lm[2]); sp[3] = softplusf_(-lm[3]);
            f32x4 CA = (f32x4){1.f, 1.f, 1.f, 1.f}, CB = (f32x4){0.f, 0.f, 0.f, 0.f};
#pragma unroll
            for (int m = 0; m < 4; ++m) {
                f32x4 aR = (f32x4){0.f, 0.f, 0.f, 0.f}, aI = (f32x4){0.f, 0.f, 0.f, 0.f};
                aR = MFMA16(Br0, A[m][0], aR); aR = MFMA16(Br1, A[m][1], aR); aI = MFMA16(Bi0, A[m][0], aI); aI = MFMA16(Bi1, A[m][1], aI);
                const int pos = 64 * n + 16 * m + fr;
                f32x4 xc = cbias;
#pragma unroll
                for (int j = 0; j < 4; ++j) {
                    const bf16_t* Pu = P + ((long)R0 + 16 * m - 3 + j) * PN + PC_RGX + du;
                    u32x2 raw = *(const u32x2*)(Pu + loffT); if (pos - 3 + j < 0) raw = (u32x2){0u, 0u};
                    const f32x4 xv = (f32x4){blo(raw.x), bhi(raw.x), blo(raw.y), bhi(raw.y)};
                    xc += (j == 0 ? w0 : (j == 1 ? w1 : (j == 2 ? w2 : w3))) * xv;
                }
                const bf16_t* Pg = P + (R0 + 16 * m) * PN + du;
                const u32x2 ry = *(const u32x2*)(Pg + PC_RGY + loffT), rg = *(const u32x2*)(Pg + PC_GA + loffT);
                f32x4 av, bv;
#pragma unroll
                for (int e = 0; e < 4; ++e) {
                    const float r = sigmoidf_(aR[e] + brd[e]), ig = sigmoidf_(aI[e] + bid[e]);
                    const float la = -8.0f * r * sp[e];
                    av[e] = __expf(la); bv[e] = __builtin_amdgcn_sqrtf(one_minus_exp(2.0f * la)) * ig * xc[e];
                }
#define RG_SCAN(ctrl) do { _Pragma("unroll") for (int e = 0; e < 4; ++e) { \
                    const float ap = __int_as_float(__builtin_amdgcn_update_dpp(0x3f800000, __float_as_int(av[e]), ctrl, 0xf, 0xf, false)); \
                    const float bp = __int_as_float(__builtin_amdgcn_update_dpp(0, __float_as_int(bv[e]), ctrl, 0xf, 0xf, false)); \
                    bv[e] = av[e] * bp + bv[e]; av[e] = ap * av[e]; } } while (0)
                RG_SCAN(0x111); RG_SCAN(0x112); RG_SCAN(0x114); RG_SCAN(0x118);
#undef RG_SCAN
                f32x4 Fa, Fb;
#pragma unroll
                for (int e = 0; e < 4; ++e) { Fa[e] = __shfl(av[e], (lane & 48) | 15); Fb[e] = __shfl(bv[e], (lane & 48) | 15); }
                const float gy[4] = {blo(ry.x), bhi(ry.x), blo(ry.y), bhi(ry.y)}, gg[4] = {blo(rg.x), bhi(rg.x), blo(rg.y), bhi(rg.y)};
                float oa[4], pa[4];
#pragma unroll
                for (int e = 0; e < 4; ++e) {
                    const float Aj = CA[e] * av[e], Bj = av[e] * CB[e] + bv[e];
                    const float gm = geluf_(gy[e]) * sigmoidf_(gg[e]);
                    oa[e] = Bj * gm; pa[e] = Aj * gm;
                }
                const size_t oo = (R0 + 16 * m) * D + du;
                { u32x2 wv; wv.x = pk2(oa[0], oa[1]); wv.y = pk2(oa[2], oa[3]); *(u32x2*)(OA + oo + loffTO) = wv; wv.x = pk2(pa[0], pa[1]); wv.y = pk2(pa[2], pa[3]); *(u32x2*)(PA + oo + loffTO) = wv; }
                const f32x4 nCa = CA * Fa, nCb = Fa * CB + Fb; CA = nCa; CB = nCb;
                __builtin_amdgcn_sched_barrier(0);
            }
            if (fr == 0) { const size_t o = ((size_t)b * NCHK + n) * D + du; *(f32x4*)(Atot + o + l4) = CA; *(f32x4*)(Btot + o + l4) = CB; }
        }
    }
}

constexpr int LQ = 136;
constexpr int GRP_BYTES = 63488;
static_assert(2 * GRP_BYTES <= LDS_BYTES, "lds");

__device__ void gdn_prep(const Params& p, int l, int b, int n, unsigned char* smem, int tid) {
    const int g = __builtin_amdgcn_readfirstlane(tid >> 8), gt = tid & 255, gw = __builtin_amdgcn_readfirstlane((tid >> 6) & 3), lane = tid & 63, fr = lane & 15, fq = lane >> 4;
    unsigned goff = (unsigned)g * GRP_BYTES; asm volatile("v_mov_b32 %0, %0" : "+v"(goff));
    LAS unsigned char* base = (LAS unsigned char*)smem + goff;
    LAS bf16_t* qn = (LAS bf16_t*)base; LAS bf16_t* kn = qn + 64 * LQ; LAS bf16_t* vv = kn + 64 * LQ;
    LAS bf16_t* Lb = (LAS bf16_t*)(base + 53248); LAS float* gcs = (LAS float*)(base + 62464);
    LAS bf16_t* XT = (LAS bf16_t*)base; LAS float* Ub = (LAS float*)(base + 36864);
    asm volatile("" : "+v"(kn)); asm volatile("" : "+v"(vv)); asm volatile("" : "+v"(Lb)); asm volatile("" : "+v"(gcs)); asm volatile("" : "+v"(Ub));
    LAS float* bts = gcs + 64; LAS float* qs = gcs + 128; LAS float* ks = gcs + 192;
    const bf16_t* P_ = (const bf16_t*)(p.ws + WS_P);
    unsigned char* prep = p.ws + WS_PREP;
    bf16_t* QD_ = (bf16_t*)(prep + PR_QD); bf16_t* KT_ = (bf16_t*)(prep + PR_KT); bf16_t* WQ_ = (bf16_t*)(prep + PR_WQ);
    float* UU_ = (float*)(prep + PR_UU); bf16_t* AI_ = (bf16_t*)(prep + PR_AI); float* GL_ = (float*)(prep + PR_GL);
    const float* gcw_ = p.in[20] + (size_t)l * 4 * CCH;
    const size_t R0 = (size_t)b * SEQ + 64 * n;
    const unsigned loP = (unsigned)((lane >> 2) * PN + 32 * (lane & 3)), loW = (unsigned)(32 * (lane & 3)), loAI = (unsigned)(256 * fq + fr);
    const unsigned loQD = (unsigned)((lane >> 2) * 128 + (lane & 3) * 32), loKT = (unsigned)((lane >> 1) * 64 + (lane & 1) * 32), loL = (unsigned)lane, loLP = (unsigned)(lane * PN);
    const unsigned loW2 = (unsigned)(8 * (lane & 15)), loP2 = (unsigned)((lane >> 4) * 16 * PN + 8 * (lane & 15));
#pragma unroll 1
    for (int pr = 0; pr < 4; ++pr) {
        int zero; asm volatile("s_mov_b32 %0, 0" : "=s"(zero));
        const bf16_t* P = P_ + zero; bf16_t* QD = QD_ + zero; bf16_t* KT = KT_ + zero; bf16_t* WQ = WQ_ + zero; float* UU = UU_ + zero; bf16_t* AI = AI_ + zero; float* GL = GL_ + zero;
        const float* gcw = gcw_ + zero;
        const int h = 2 * pr + g;
        const size_t ci = ((size_t)b * NH + h) * NCHK + n;
#ifndef NO_S1
        if (gw < 3) {
            const int X = gw, tr = lane >> 4, cg = lane & 15, t0 = 16 * tr;
            const float* wu = gcw + X * 1024 + 128 * h;
            f32x4 w[4][2];
#pragma unroll
            for (int j = 0; j < 4; ++j) { w[j][0] = *(const f32x4*)(wu + j * CCH + loW2); w[j][1] = *(const f32x4*)(wu + j * CCH + 4 + loW2); }
            const bf16_t* Pu = P + ((long)R0 - 3) * PN + PC_Q + X * 1024 + 128 * h;
            LAS bf16_t* dst = (X == 0 ? qn : (X == 1 ? kn : vv)) + t0 * LQ + 8 * cg;
            float ssum[16];
            float acc[4][8];
#pragma unroll
            for (int hf = 0; hf < 2; ++hf) {
                u32x4 raw[10];
#pragma unroll
                for (int rr = 0; rr < 10; ++rr) { const int r = 10 * hf + rr; if (r < 19) { raw[rr] = *(const u32x4*)(Pu + (long)r * PN + loP2); if (64 * n + t0 + r - 3 < 0) raw[rr] = (u32x4){0u, 0u, 0u, 0u}; } }
#pragma unroll
                for (int rr = 0; rr < 10; ++rr) {
                    const int r = 10 * hf + rr;
                    if (r < 19) {
                        float xv[8]; unpack8(raw[rr], xv);
#pragma unroll
                        for (int j = 0; j < 4; ++j) {
                            const int i = r - j;
                            if (i >= 0 && i < 16) {
                                const int sl = i & 3;
                                if (j == 0) {
#pragma unroll
                                    for (int e = 0; e < 8; ++e) acc[sl][e] = w[0][e >> 2][e & 3] * xv[e];
                                } else {
#pragma unroll
                                    for (int e = 0; e < 8; ++e) acc[sl][e] += w[j][e >> 2][e & 3] * xv[e];
                                }
                            }
                        }
                        if (r >= 3) {
                            const int i = r - 3, sl = i & 3;
                            float o8[8]; float sq_ = 0.f;
#pragma unroll
                            for (int e = 0; e < 8; ++e) { o8[e] = siluf_(acc[sl][e]); sq_ += o8[e] * o8[e]; }
                            ssum[i] = sq_;
                            *(LAS u32x4*)(dst + i * LQ) = pack8(o8);
                            asm volatile("" : "+v"(ssum[i]));
                        }
                    }
                }
                __builtin_amdgcn_sched_barrier(0);
            }
            if (X < 2) {
                float mine = 0.f;
#pragma unroll
                for (int i = 0; i < 16; ++i) { float v_ = ssum[i]; v_ += __shfl_xor(v_, 1); v_ += __shfl_xor(v_, 2); v_ += __shfl_xor(v_, 4); v_ += __shfl_xor(v_, 8); if (cg == i) mine = v_; }
                (X == 0 ? qs : ks)[t0 + cg] = rsqrtf(mine + 1e-6f) * (X == 0 ? 0.08838834764831845f : 1.0f);
            }
        } else {
            const bf16_t* Pg = P + R0 * PN + PC_A + h;
            const float ga = bf2f(Pg[loLP]), gb = bf2f((Pg + 8)[loLP]);
            const float beta = sigmoidf_(gb);
            float gv = -__expf(p.in[21][l * NH + h]) * softplusf_(ga + p.in[22][l * NH + h]);
#pragma unroll
            for (int off = 1; off < 64; off <<= 1) { const float o = __shfl_up(gv, off); if (lane >= off) gv += o; }
            gcs[lane] = gv; bts[lane] = beta;
        }
        __syncthreads();
#endif
#ifndef NO_S2
        { f32x4 aKK[4], aQK[4];
#pragma unroll
          for (int nb = 0; nb < 4; ++nb) { aKK[nb] = (f32x4){0.f, 0.f, 0.f, 0.f}; aQK[nb] = (f32x4){0.f, 0.f, 0.f, 0.f}; }
#pragma unroll
          for (int ks = 0; ks < 4; ++ks) {
              const bf16x8 Ak = *(const LAS bf16x8*)(kn + (16 * gw + fr) * LQ + 32 * ks + 8 * fq), Aq = *(const LAS bf16x8*)(qn + (16 * gw + fr) * LQ + 32 * ks + 8 * fq);
#pragma unroll
              for (int nb = 0; nb < 4; ++nb) { const bf16x8 Bk = *(const LAS bf16x8*)(kn + (16 * nb + fr) * LQ + 32 * ks + 8 * fq); aKK[nb] = MFMA16(Ak, Bk, aKK[nb]); aQK[nb] = MFMA16(Aq, Bk, aQK[nb]); }
          }
#pragma unroll
          for (int nb = 0; nb < 4; ++nb) {
              const int sx = 16 * nb + fr; const float gs = gcs[sx], kss = ks[sx];
#pragma unroll
              for (int j = 0; j < 4; ++j) {
                  const int c = 16 * gw + 4 * fq + j; const float dec = __expf(fminf(gcs[c] - gs, 0.f));
                  Lb[c * 72 + sx] = f2bf((c > sx) ? bts[c] * ks[c] * kss * aKK[nb][j] * dec : 0.f);
                  (AI + ci * 4096 + (16 * gw + j) * 64 + 16 * nb)[loAI] = f2bf((c >= sx) ? qs[c] * kss * aQK[nb][j] * dec : 0.f);
              }
          } }
#endif
#ifndef NO_S4
        { const int t = gt >> 2, part = gt & 3; const float e = __expf(gcs[t]) * qs[t];
#pragma unroll
          for (int c4 = 0; c4 < 4; ++c4) { const u32x4 raw = *(const LAS u32x4*)(qn + t * LQ + 32 * part + 8 * c4); float v[8]; unpack8(raw, v);
#pragma unroll
              for (int i = 0; i < 8; ++i) v[i] *= e;
              *(u32x4*)(QD + ci * 8192 + 16 * gw * 128 + 8 * c4 + loQD) = pack8(v); }
          const int kd = gt >> 1, half = gt & 1; const float glast = gcs[63];
#pragma unroll
          for (int c4 = 0; c4 < 4; ++c4) { float v[8];
#pragma unroll
              for (int i = 0; i < 8; ++i) { const int tt = 32 * half + 8 * c4 + i; v[i] = bf2f(kn[tt * LQ + kd]) * ks[tt] * __expf(glast - gcs[tt]); }
              *(u32x4*)(KT + ci * 8192 + 32 * gw * 64 + 8 * c4 + loKT) = pack8(v); }
          if (gt == 0) GL[ci] = __expf(glast); }
#endif
#ifndef NO_S3
        { float x[64];
          if (gt < 128) {
#pragma unroll
              for (int t = 0; t < 64; ++t) { x[t] = bf2f(vv[t * LQ + gt]) * bts[t]; if ((t & 7) == 7) __builtin_amdgcn_sched_barrier(0); }
          } else {
#pragma unroll
              for (int t = 0; t < 64; ++t) { x[t] = bf2f(kn[t * LQ + gt - 128]) * bts[t] * ks[t] * __expf(gcs[t]); if ((t & 7) == 7) __builtin_amdgcn_sched_barrier(0); }
          }
          __syncthreads();
          LAS bf16_t* xrow = XT + gt * 72;
          LAS float* ucol = Ub + 64 * gw + lane;
#pragma unroll
          for (int bi = 0; bi < 4; ++bi) {
              if (bi > 0) {
                  f32x4 acc[4];
#pragma unroll
                  for (int q = 0; q < 4; ++q) acc[q] = (f32x4){0.f, 0.f, 0.f, 0.f};
#pragma unroll
                  for (int ks = 0; ks < (bi == 3 ? 2 : 1); ++ks) {
                      bf16x8 Af = *(const LAS bf16x8*)(Lb + (16 * bi + fr) * 72 + 32 * ks + 8 * fq);
                      if (32 * ks + 8 * fq >= 16 * bi) Af = (bf16x8){0, 0, 0, 0, 0, 0, 0, 0};
#pragma unroll
                      for (int q = 0; q < 4; ++q) { const bf16x8 Bf = *(const LAS bf16x8*)(XT + (64 * gw + 16 * q + fr) * 72 + 32 * ks + 8 * fq); acc[q] = MFMA16(Af, Bf, acc[q]); }
                  }
#pragma unroll
                  for (int q = 0; q < 4; ++q)
#pragma unroll
                      for (int j = 0; j < 4; ++j) Ub[(4 * fq + j) * 256 + 64 * gw + 16 * q + fr] = acc[q][j];
                  asm volatile("s_waitcnt lgkmcnt(0)" ::: "memory");
#pragma unroll
                  for (int i = 0; i < 16; ++i) x[16 * bi + i] -= ucol[i * 256];
                  __builtin_amdgcn_sched_barrier(0);
              }
#pragma unroll
              for (int i = 1; i < 16; ++i) {
                  float lv[16];
                  unpack8(*(const LAS u32x4*)(Lb + (16 * bi + i) * 72 + 16 * bi), lv);
                  if (i > 8) unpack8(*(const LAS u32x4*)(Lb + (16 * bi + i) * 72 + 16 * bi + 8), lv + 8);
#pragma unroll
                  for (int j = 0; j < i; ++j) x[16 * bi + i] -= lv[j] * x[16 * bi + j];
                  asm volatile("" : "+v"(x[16 * bi + i]));
              }
              if (bi < 3) {
                  *(LAS u32x4*)(xrow + 16 * bi) = pack8(x + 16 * bi); *(LAS u32x4*)(xrow + 16 * bi + 8) = pack8(x + 16 * bi + 8);
                  asm volatile("s_waitcnt lgkmcnt(0)" ::: "memory");
              }
          }
          if (gt < 128) {
#pragma unroll
              for (int t = 0; t < 64; ++t) (UU + ci * 8192 + t * 128 + 64 * gw)[loL] = x[t];
          } else {
#pragma unroll
              for (int t = 0; t < 64; ++t) (WQ + ci * 8192 + t * 128 + 64 * (gw - 2))[loL] = f2bf(x[t]);
          } }
#endif
        __syncthreads();
    }
}

__device__ void phase_m1(const Params& p, int l, unsigned char* smem, const int tid, const int dbl) {
    const int wid = __builtin_amdgcn_readfirstlane(tid >> 6), lane = tid & 63;
#ifndef NO_RG
    for (int rep = 0; rep < ((dbl >> 13) & 1) + 1; ++rep)
    for (int u = blockIdx.x; u < NB * NCHK; u += gridDim.x) rg_prompt(p, l, u / NCHK, u % NCHK, wid, lane);
#endif
    __builtin_amdgcn_sched_barrier(0);
#ifndef NO_GDN
    for (int rep = 0; rep < ((dbl >> 14) & 1) + 1; ++rep)
    for (int u = blockIdx.x; u < NB * NCHK; u += gridDim.x) gdn_prep(p, l, u / NCHK, u % NCHK, smem, tid);
#endif
}

#define LBAR() do { asm volatile("s_waitcnt lgkmcnt(0)" ::: "memory"); __builtin_amdgcn_s_barrier(); asm volatile("" ::: "memory"); } while (0)
__device__ void phase_m2(const Params& p, int l, unsigned char* smem, const int tid) {
    const int wid = __builtin_amdgcn_readfirstlane(tid >> 6), lane = tid & 63, fr = lane & 15, fq = lane >> 4;
    bf16_t* St = (bf16_t*)smem;
    bf16_t* Vt = St + 32 * LQ;
    unsigned char* prep = p.ws + WS_PREP;
    const bf16_t* QD = (const bf16_t*)(prep + PR_QD); const bf16_t* KT = (const bf16_t*)(prep + PR_KT); const bf16_t* WQ = (const bf16_t*)(prep + PR_WQ);
    const float* UU = (const float*)(prep + PR_UU); const bf16_t* AI = (const bf16_t*)(prep + PR_AI); const float* GL = (const float*)(prep + PR_GL);
    float* Ob = (float*)(p.ws + WS_O);
    const int mb = wid & 3, role = wid >> 2;
    for (int chn = blockIdx.x; chn < NB * NH * 4; chn += gridDim.x) {
        const int xcd = chn & 7, idx = chn >> 3, sl = idx & 3, bh = xcd * 8 + (idx >> 2), b = bh >> 3, h = bh & 7;
        f32x4 Sacc[2];
        Sacc[0] = (f32x4){0.f, 0.f, 0.f, 0.f}; Sacc[1] = (f32x4){0.f, 0.f, 0.f, 0.f};
        __syncthreads();
        for (int i = tid; i < 32 * LQ / 2; i += 512) ((unsigned*)St)[i] = 0u;
        __syncthreads();
        bf16x8 Af[4], Kf[2], Gf[2]; float eg; float uv[2][4];
#define M2_LOAD(AF, KF, GF, EG, UV, nn) do { const size_t ci_ = (size_t)bh * NCHK + (nn); \
            const bf16_t* Asrc_ = (role == 0 ? WQ : QD) + ci_ * 8192 + (16 * mb + fr) * 128 + 8 * fq; \
            _Pragma("unroll") for (int ks = 0; ks < 4; ++ks) AF[ks] = *(const bf16x8*)(Asrc_ + 32 * ks); \
            _Pragma("unroll") for (int ks = 0; ks < 2; ++ks) { KF[ks] = *(const bf16x8*)(KT + ci_ * 8192 + (16 * wid + fr) * 64 + 32 * ks + 8 * fq); GF[ks] = *(const bf16x8*)(AI + ci_ * 4096 + (16 * mb + fr) * 64 + 32 * ks + 8 * fq); } \
            EG = GL[ci_]; \
            _Pragma("unroll") for (int nb = 0; nb < 2; ++nb) _Pragma("unroll") for (int j = 0; j < 4; ++j) UV[nb][j] = UU[ci_ * 8192 + (16 * mb + 4 * fq + j) * 128 + 32 * sl + 16 * nb + fr]; } while (0)
        M2_LOAD(Af, Kf, Gf, eg, uv, 0);
#pragma unroll 1
        for (int n = 0; n < NCHK; ++n) {
            bf16x8 Afn[4], Kfn[2], Gfn[2]; float egn; float uvn[2][4];
            { const int nn = n + 1 < NCHK ? n + 1 : n; M2_LOAD(Afn, Kfn, Gfn, egn, uvn, nn); }
            f32x4 acc[2]; acc[0] = (f32x4){0.f, 0.f, 0.f, 0.f}; acc[1] = (f32x4){0.f, 0.f, 0.f, 0.f};
#pragma unroll
            for (int ks = 0; ks < 4; ++ks)
#pragma unroll
                for (int nb = 0; nb < 2; ++nb) { const bf16x8 Bf = *(const bf16x8*)(St + (16 * nb + fr) * LQ + 32 * ks + 8 * fq); acc[nb] = MFMA16(Af[ks], Bf, acc[nb]); }
            if (role == 0) {
#pragma unroll
                for (int nb = 0; nb < 2; ++nb) { u32x2 w; w.x = pk2(uv[nb][0] - acc[nb][0], uv[nb][1] - acc[nb][1]); w.y = pk2(uv[nb][2] - acc[nb][2], uv[nb][3] - acc[nb][3]);
                    *(u32x2*)(Vt + (16 * nb + fr) * 72 + 16 * mb + 4 * fq) = w; }
            }
            LBAR();
            bf16x8 Vf[2][2];
#pragma unroll
            for (int ks = 0; ks < 2; ++ks)
#pragma unroll
                for (int nb = 0; nb < 2; ++nb) Vf[ks][nb] = *(const bf16x8*)(Vt + (16 * nb + fr) * 72 + 32 * ks + 8 * fq);
            if (role == 1) {
#pragma unroll
                for (int ks = 0; ks < 2; ++ks)
#pragma unroll
                    for (int nb = 0; nb < 2; ++nb) acc[nb] = MFMA16(Gf[ks], Vf[ks][nb], acc[nb]);
#pragma unroll
                for (int nb = 0; nb < 2; ++nb)
#pragma unroll
                    for (int j = 0; j < 4; ++j) Ob[((size_t)b * SEQ + 64 * n + 16 * mb + 4 * fq + j) * D + 128 * h + 32 * sl + 16 * nb + fr] = acc[nb][j];
            }
            Sacc[0] = Sacc[0] * eg; Sacc[1] = Sacc[1] * eg;
#pragma unroll
            for (int ks = 0; ks < 2; ++ks)
#pragma unroll
                for (int nb = 0; nb < 2; ++nb) Sacc[nb] = MFMA16(Kf[ks], Vf[ks][nb], Sacc[nb]);
#pragma unroll
            for (int nb = 0; nb < 2; ++nb) { u32x2 w; w.x = pk2(Sacc[nb][0], Sacc[nb][1]); w.y = pk2(Sacc[nb][2], Sacc[nb][3]); *(u32x2*)(St + (16 * nb + fr) * LQ + 16 * wid + 4 * fq) = w; }
            LBAR();
#pragma unroll
            for (int ks = 0; ks < 4; ++ks) Af[ks] = Afn[ks];
#pragma unroll
            for (int ks = 0; ks < 2; ++ks) { Kf[ks] = Kfn[ks]; Gf[ks] = Gfn[ks]; }
            eg = egn;
#pragma unroll
            for (int nb = 0; nb < 2; ++nb)
#pragma unroll
                for (int j = 0; j < 4; ++j) uv[nb][j] = uvn[nb][j];
        }
#undef M2_LOAD
        float* So = p.out + O_PS + (((size_t)l * NB + b) * NH + h) * 128 * 128;
#pragma unroll
        for (int nb = 0; nb < 2; ++nb)
#pragma unroll
            for (int j = 0; j < 4; ++j) So[(16 * wid + 4 * fq + j) * 128 + 32 * sl + 16 * nb + fr] = Sacc[nb][j];
    }
}

__device__ void m3_prompt(const Params& p, int l, int b, int n, unsigned char* smem, int tid) {
    const int wid = __builtin_amdgcn_readfirstlane(tid >> 6), lane = tid & 63;
    float* hin = (float*)smem;
    const float* Atot = (const float*)(p.ws + WS_TOT); const float* Btot = Atot + (size_t)NB * NCHK * D;
    const bf16_t* P = (const bf16_t*)(p.ws + WS_P);
    const bf16_t* OA = (const bf16_t*)(p.ws + WS_OA); const bf16_t* PA = (const bf16_t*)(p.ws + WS_PA);
    const float* Ob = (const float*)(p.ws + WS_O); bf16_t* Mg = (bf16_t*)(p.ws + WS_MG);
    __syncthreads();
    for (int c = tid; c < D; c += 512) {
        float hv = 0.f;
        for (int i0 = 0; i0 < n; i0 += 8) {
            float av[8], bv[8];
#pragma unroll
            for (int e = 0; e < 8; ++e) { const bool ok = i0 + e < n; const size_t o = ((size_t)b * NCHK + (ok ? i0 + e : 0)) * D + c; const float a_ = Atot[o], b_ = Btot[o]; av[e] = ok ? a_ : 1.f; bv[e] = ok ? b_ : 0.f; }
#pragma unroll
            for (int e = 0; e < 8; ++e) hv = av[e] * hv + bv[e];
        }
        hin[c] = hv;
        if (n == NCHK - 1) { const size_t o = ((size_t)b * NCHK + n) * D + c; p.out[O_PH + ((size_t)l * NB + b) * D + c] = Atot[o] * hv + Btot[o]; }
    }
    __syncthreads();
    const float* nw = p.in[23] + (size_t)l * 128;
    const int c0 = 16 * lane;
    float nwv[16], hv[16];
#pragma unroll
    for (int i = 0; i < 16; ++i) { nwv[i] = nw[(c0 + i) & 127]; hv[i] = hin[c0 + i]; }
    for (int rr = wid; rr < 64; rr += 8) {
        const size_t R = (size_t)b * SEQ + 64 * n + rr;
        float o[16], oa[16], pa[16], z[16], gb[16];
#pragma unroll
        for (int q = 0; q < 4; ++q) { const f32x4 v = *(const f32x4*)(Ob + R * D + c0 + 4 * q); o[4 * q] = v[0]; o[4 * q + 1] = v[1]; o[4 * q + 2] = v[2]; o[4 * q + 3] = v[3]; }
#pragma unroll
        for (int q = 0; q < 2; ++q) {
            unpack8(*(const u32x4*)(OA + R * D + c0 + 8 * q), oa + 8 * q); unpack8(*(const u32x4*)(PA + R * D + c0 + 8 * q), pa + 8 * q);
            unpack8(*(const u32x4*)(P + R * PN + PC_Z + c0 + 8 * q), z + 8 * q); unpack8(*(const u32x4*)(P + R * PN + PC_GB + c0 + 8 * q), gb + 8 * q);
        }
        float ss = 0.f;
#pragma unroll
        for (int i = 0; i < 16; ++i) ss += o[i] * o[i];
        ss += __shfl_xor(ss, 1); ss += __shfl_xor(ss, 2); ss += __shfl_xor(ss, 4);
        const float rstd = rsqrtf(ss * (1.0f / 128.0f) + 1e-6f);
        float mg[16];
#pragma unroll
        for (int i = 0; i < 16; ++i) mg[i] = oa[i] + pa[i] * hv[i] + sigmoidf_(gb[i]) * (o[i] * rstd * nwv[i] * siluf_(z[i]));
        *(u32x4*)(Mg + R * D + c0) = pack8(mg); *(u32x4*)(Mg + R * D + c0 + 8) = pack8(mg + 8);
    }
    if (n == NCHK - 1) {
        for (int i = tid; i < 3 * D; i += 512) { const int j = i / D, c = i % D; p.out[O_PRC + (((size_t)l * NB + b) * 3 + j) * D + c] = bf2f(P[((size_t)b * SEQ + SEQ - 3 + j) * PN + PC_RGX + c]); }
        for (int i = tid; i < 3 * CCH; i += 512) { const int j = i / CCH, c = i % CCH; p.out[O_PGC + (((size_t)l * NB + b) * 3 + j) * CCH + c] = bf2f(P[((size_t)b * SEQ + SEQ - 3 + j) * PN + PC_Q + c]); }
    }
}

__device__ void m3_sample(const Params& p, int l, int bs, int h, unsigned char* smem, int tid) {
    float* sq = (float*)smem;
    float* sxc = sq + 384;
    float* red = sxc + 128;
    float* part = red + 16;
    const bf16_t* P = (const bf16_t*)(p.ws + WS_P);
    bf16_t* Mg = (bf16_t*)(p.ws + WS_MG);
    const size_t R = (size_t)MP + bs;
    const int wid = __builtin_amdgcn_readfirstlane(tid >> 6), lane = tid & 63;
    const int kq = tid >> 7, v = tid & 127;
    const int d = 128 * h + v, blk = d >> 6, dd = d & 63, xb = (v >> 6) * 64;
    const float* S0 = p.in[4] + ((((size_t)l * DEC + bs) * NH + h) * 128 + 32 * kq) * 128 + v;
    float s0[32], wr16[16], wi16[16];
#pragma unroll
    for (int i = 0; i < 32; ++i) s0[i] = __builtin_nontemporal_load(S0 + (size_t)i * 128);
    { const float* wr = p.in[15] + (((size_t)l * 16 + blk) * 64 + 16 * kq) * 64 + dd; const float* wi = p.in[17] + (((size_t)l * 16 + blk) * 64 + 16 * kq) * 64 + dd;
#pragma unroll
      for (int c = 0; c < 16; ++c) { wr16[c] = wr[c * 64]; wi16[c] = wi[c * 64]; } }
    __syncthreads();
    if (tid < 384) {
        const int X = tid >> 7, i = tid & 127, chp = X * 1024 + 128 * h + i;
        const float cur = bf2f(P[R * PN + PC_Q + chp]);
        const float* hist = p.in[5] + (((size_t)l * DEC + bs) * 3) * CCH + chp;
        const float h0 = hist[0], h1 = hist[CCH], h2 = hist[2 * CCH];
        const float* w = p.in[20] + (size_t)l * 4 * CCH + chp;
        sq[tid] = siluf_(w[0] * h0 + w[CCH] * h1 + w[2 * CCH] * h2 + w[3 * CCH] * cur);
        float* so = p.out + O_SGC + (((size_t)l * DEC + bs) * 3) * CCH + chp;
        so[0] = h1; so[CCH] = h2; so[2 * CCH] = cur;
    } else {
        const int dch = 128 * h + (tid - 384);
        const float cur = bf2f(P[R * PN + PC_RGX + dch]);
        const float* hist = p.in[3] + (((size_t)l * DEC + bs) * 3) * D + dch;
        const float h0 = hist[0], h1 = hist[D], h2 = hist[2 * D];
        const float* w = p.in[13] + (size_t)l * 4 * D + dch;
        sxc[tid - 384] = w[0] * h0 + w[D] * h1 + w[2 * D] * h2 + w[3 * D] * cur + p.in[14][(size_t)l * D + dch];
        float* so = p.out + O_SRC + (((size_t)l * DEC + bs) * 3) * D + dch;
        so[0] = h1; so[D] = h2; so[2 * D] = cur;
    }
    __syncthreads();
    if (wid < 3) {
        const float a0 = wid == 1 ? sq[128 + lane] : sq[lane], a1 = wid == 1 ? sq[192 + lane] : sq[64 + lane];
        const float b0 = wid == 0 ? a0 : sq[128 + lane], b1 = wid == 0 ? a1 : sq[192 + lane];
        const float sm = wave_sum(a0 * b0 + a1 * b1);
        if (lane == 0) red[wid] = sm;
    }
    { float kS = 0.f, qS = 0.f, rp = 0.f, ip = 0.f;
#pragma unroll
      for (int i = 0; i < 32; ++i) { kS += sq[128 + 32 * kq + i] * s0[i]; qS += sq[32 * kq + i] * s0[i]; }
#pragma unroll
      for (int c = 0; c < 16; ++c) { const float x = sxc[xb + 16 * kq + c]; rp += x * wr16[c]; ip += x * wi16[c]; }
      part[kq * 128 + v] = kS; part[512 + kq * 128 + v] = qS; part[1024 + kq * 128 + v] = rp; part[1536 + kq * 128 + v] = ip; }
    __syncthreads();
    const float qsc = rsqrtf(red[0] + 1e-6f) * 0.08838834764831845f, ksc = rsqrtf(red[1] + 1e-6f);
    const float qk = red[2] * qsc * ksc;
    const float ga = bf2f(P[R * PN + PC_A + h]), gb_ = bf2f(P[R * PN + PC_B + h]);
    const float beta = sigmoidf_(gb_);
    const float eg = __expf(-__expf(p.in[21][l * NH + h]) * softplusf_(ga + p.in[22][l * NH + h]));
    const float kSt = (part[v] + part[128 + v] + part[256 + v] + part[384 + v]) * ksc;
    const float qSt = (part[512 + v] + part[640 + v] + part[768 + v] + part[896 + v]) * qsc;
    const float vnew = beta * (sq[256 + v] - eg * kSt);
    const float o = eg * qSt + qk * vnew;
    float* S1 = p.out + O_SS + ((((size_t)l * DEC + bs) * NH + h) * 128 + 32 * kq) * 128 + v;
#pragma unroll
    for (int i = 0; i < 32; ++i) __builtin_nontemporal_store(s0[i] * eg + sq[128 + 32 * kq + i] * ksc * vnew, S1 + (size_t)i * 128);
    if (wid < 2) { const float sm = wave_sum(o * o); if (lane == 0) red[4 + wid] = sm; }
    __syncthreads();
    if (tid < 128) {
        const float rstd = rsqrtf((red[4] + red[5]) * (1.0f / 128.0f) + 1e-6f);
        const float rp = p.in[16][(size_t)l * D + d] + part[1024 + v] + part[1152 + v] + part[1280 + v] + part[1408 + v];
        const float ip = p.in[18][(size_t)l * D + d] + part[1536 + v] + part[1664 + v] + part[1792 + v] + part[1920 + v];
        const float r = sigmoidf_(rp), ig = sigmoidf_(ip);
        const float la = -8.0f * r * softplusf_(-p.in[19][(size_t)l * D + d]);
        const float a = __expf(la);
        const float hnew = a * p.in[2][((size_t)l * DEC + bs) * D + d] + __builtin_amdgcn_sqrtf(one_minus_exp(2.0f * la)) * (ig * sxc[v]);
        p.out[O_SH + ((size_t)l * DEC + bs) * D + d] = hnew;
        const float outa = hnew * geluf_(bf2f(P[R * PN + PC_RGY + d]));
        const float outb = o * rstd * p.in[23][(size_t)l * 128 + v] * siluf_(bf2f(P[R * PN + PC_Z + d]));
        Mg[R * D + d] = f2bf(sigmoidf_(bf2f(P[R * PN + PC_GA + d])) * outa + sigmoidf_(bf2f(P[R * PN + PC_GB + d])) * outb);
    }
}

__device__ void phase_m3(const Params& p, int l, unsigned char* smem, const int tid) {
    const int NU = NB * NCHK + DEC * NH;
    for (int u = blockIdx.x; u < NU; u += gridDim.x) {
        if (u < NB * NCHK) m3_prompt(p, l, u / NCHK, u % NCHK, smem, tid);
        else { const int s = u - NB * NCHK; m3_sample(p, l, s >> 3, s & 7, smem, tid); }
    }
}

constexpr int PPL = 9;
constexpr int NPH = 1 + PPL * DEPTH;
__global__ void __launch_bounds__(512) mega(Params p, int ph_lo, int ph_hi, int dbl) {
    extern __shared__ __attribute__((aligned(16))) unsigned char smem[];
    LAS unsigned char* lds = (LAS unsigned char*)smem;
    bf16_t* WT = (bf16_t*)(p.ws + WS_WT);
    float* Xf = (float*)(p.ws + WS_XF); bf16_t* Xb = (bf16_t*)(p.ws + WS_XB);
    bf16_t* Pb = (bf16_t*)(p.ws + WS_P); bf16_t* Hb = Pb; bf16_t* Mg = (bf16_t*)(p.ws + WS_MG);
    float* Ypre = (float*)(p.ws + WS_PREP);
    for (int ph = ph_lo; ph < ph_hi; ++ph) {
        if (ph > ph_lo) {
            if (ph_hi < 0) cg::this_grid().sync();
            grid_barrier((unsigned*)(p.ws + WS_BAR), (unsigned)ph * gridDim.x);
        }
        const int reps = ((dbl >> (ph == 0 ? 12 : (ph - 1) % PPL)) & 1) + 1;
        for (int rep = 0; rep < reps; ++rep) {
        int tid; asm volatile("v_mov_b32 %0, %1" : "=v"(tid) : "v"((int)threadIdx.x));
        if (ph == 0) { phase_prep(p, smem, tid); continue; }
        const int l = (ph - 1) / PPL, s = (ph - 1) % PPL;
        const bf16_t* wt = WT + (size_t)l * LW_END;
        pg8::StaticOrder S;
#ifdef ONLY_M1
        if (s == 3) phase_m1(p, l, smem, tid, dbl);
        continue;
#endif
        switch (s) {
        case 0: case 7: {
            pg8::Gemm g{Xb, wt + (s == 0 ? LW_UP1 : LW_UP2), MPAD, 2 * DFF, D}; S.init(MPAD, 2 * DFF, gridDim.x, blockIdx.x);
            pg8::EpiSwiglu E{Hb, DFF}; pg8::gemm_phase(lds, g, S, E, tid); } break;
        case 1: case 8: {
            const int gi = s == 1 ? 6 : 30; const unsigned gen = (unsigned)(l * 3 + (s == 1 ? 1 : 3));
            float* outp = (s == 8 && l == DEPTH - 1) ? p.out : nullptr;
            sample_gemm_resid(Hb, DFF, wt + (s == 1 ? LW_DN1 : LW_DN2), Ypre, Xf, ALPHA, 0.5f, smem, tid);
            sample_arrive(p, tid);
            pg8::Gemm g{Hb, wt + (s == 1 ? LW_DN1 : LW_DN2), MP, D, DFF}; S.init(MP, D, gridDim.x, blockIdx.x);
            pg8::EpiResidLN E{Xf, Xb, outp, p.in[gi] + (size_t)l * D, p.in[gi + 1] + (size_t)l * D, ALPHA, 0.5f, (float*)(p.ws + WS_XCH), (unsigned*)(p.ws + WS_BAR) + 64, gen};
            pg8::gemm_phase(lds, g, S, E, tid);
            sample_ln(p, gen, Ypre, p.in[gi] + (size_t)l * D, p.in[gi + 1] + (size_t)l * D, Xf, Xb, outp, tid); } break;
        case 2: {
            pg8::Gemm g{Xb, wt + LW_WIN, MPAD, PN, D}; S.init(MPAD, PN, gridDim.x, blockIdx.x);
            pg8::EpiProj E{Pb, PN, (const float*)(p.ws + WS_BIASP) + (size_t)l * PN}; pg8::gemm_phase(lds, g, S, E, tid); } break;
        case 3: phase_m1(p, l, smem, tid, dbl); break;
        case 4: phase_m2(p, l, smem, tid); break;
        case 5: phase_m3(p, l, smem, tid); break;
        case 6: {
            const unsigned gen = (unsigned)(l * 3 + 2);
            sample_gemm_resid(Mg, D, wt + LW_WO, Ypre, Xf, ALPHA, 1.0f, smem, tid);
            sample_arrive(p, tid);
            pg8::Gemm g{Mg, wt + LW_WO, MP, D, D}; S.init(MP, D, gridDim.x, blockIdx.x);
            pg8::EpiResidLN E{Xf, Xb, nullptr, p.in[25] + (size_t)l * D, p.in[26] + (size_t)l * D, ALPHA, 1.0f, (float*)(p.ws + WS_XCH), (unsigned*)(p.ws + WS_BAR) + 64, gen};
            pg8::gemm_phase(lds, g, S, E, tid);
            sample_ln(p, gen, Ypre, p.in[25] + (size_t)l * D, p.in[26] + (size_t)l * D, Xf, Xb, nullptr, tid); } break;
        }
        }
    }
}

extern "C" void kernel_launch(void* const* d_in, const int* in_sizes, int n_in, void* d_out, int out_size, void* d_ws, size_t ws_size, hipStream_t stream) {
    static int grid = 0;
    if (grid == 0) {
        if (n_in != 32 || (size_t)out_size != O_END || ws_size < WS_END) { fprintf(stderr, "kernel_launch: unexpected shapes: n_in %d out %d ws %zu (need %zu)\n", n_in, out_size, ws_size, (size_t)WS_END); grid = -1; return; }
        int dev = 0, cus = 0, per_cu = 0;
        hipGetDevice(&dev); hipDeviceGetAttribute(&cus, hipDeviceAttributeMultiprocessorCount, dev);
        if (hipFuncSetAttribute((const void*)mega, hipFuncAttributeMaxDynamicSharedMemorySize, LDS_BYTES) != hipSuccess) { fprintf(stderr, "hipFuncSetAttribute failed\n"); grid = -1; return; }
        if (hipOccupancyMaxActiveBlocksPerMultiprocessor(&per_cu, (const void*)mega, 512, LDS_BYTES) != hipSuccess || per_cu < 1) { fprintf(stderr, "occupancy query: %d\n", per_cu); per_cu = 1; }
        (void)hipGetLastError();
        grid = cus * (per_cu > 1 ? 1 : per_cu);
    }
    if (grid < 0) return;
    Params p{};
    for (int i = 0; i < 32; ++i) p.in[i] = (const float*)d_in[i];
    p.out = (float*)d_out; p.ws = (unsigned char*)d_ws;
#if COOP
    hipMemsetAsync((char*)d_ws + WS_BAR, 0, 1024, stream);
    int lo = 0, hi = NPH, dbl = DBL;
    void* args[] = {&p, &lo, &hi, &dbl};
    hipError_t e = hipLaunchCooperativeKernel((const void*)mega, dim3(grid), dim3(512), args, LDS_BYTES, stream);
    if (e != hipSuccess) fprintf(stderr, "cooperative launch failed: %s (grid %d)\n", hipGetErrorString(e), grid);
#else
    for (int ph = 0; ph < NPH; ++ph) hipLaunchKernelGGL(mega, dim3(grid), dim3(512), LDS_BYTES, stream, p, ph, ph + 1, 0);
#endif
}
```
